# Optimizing an MI355X kernel written in HIP

```python
import math
import jax, jax.numpy as jnp
from jax import lax
import numpy as np

D_MODEL = 1024
BATCH = 16
SEQ = 2048
DEPTH = 4

GRID_W = 64
CTX_LEN = 256
HEAD_DIM = 64
GROUP_WIDTH = D_MODEL // 4
A_HEADS = GROUP_WIDTH // HEAD_DIM
A_QK_DIM = HEAD_DIM // 2
A_V_DIM = HEAD_DIM
B_HEADS = GROUP_WIDTH // HEAD_DIM
B_KEY_DIM = HEAD_DIM
B_VAL_DIM = HEAD_DIM
CHUNK = 64
C_Q_HEADS = GROUP_WIDTH // HEAD_DIM
C_KV_HEADS = C_Q_HEADS // 2
D_GROUPS = GROUP_WIDTH // HEAD_DIM
D_GROUP_DIM = HEAD_DIM
MIX_WIDTH = A_HEADS * A_V_DIM + B_HEADS * B_VAL_DIM + C_Q_HEADS * HEAD_DIM + D_GROUPS * D_GROUP_DIM
IN_SPLITS = (
    A_HEADS * 2 * A_QK_DIM, A_HEADS * 2 * A_QK_DIM, A_HEADS * A_V_DIM,
    B_HEADS * B_KEY_DIM, B_HEADS * B_KEY_DIM, B_HEADS * B_KEY_DIM,
    B_HEADS * B_VAL_DIM, B_HEADS * B_VAL_DIM,
    C_Q_HEADS * HEAD_DIM, C_KV_HEADS * HEAD_DIM, C_KV_HEADS * HEAD_DIM,
    D_GROUPS * D_GROUP_DIM,
)
IN_WIDTH = sum(IN_SPLITS)
FFN_HIDDEN = -(-8 * D_MODEL // (3 * 256)) * 256
Q_BLOCK = 128
ROPE_THETA = 10000.0
RMS_EPS = 1e-6

kernel_name = 'hybrid_parallel_heads_flow_block'

F32 = jnp.float32


def rmsnorm(x, gain):
    xf = x.astype(F32)
    y = xf * lax.rsqrt(jnp.mean(xf * xf, axis=-1, keepdims=True) + RMS_EPS)
    return (y * gain.astype(F32)).astype(x.dtype)


def modulate(h, shift, scale):
    return h * (1 + scale) + shift


def split_proj(p):
    offsets = np.cumsum(IN_SPLITS)[:-1].tolist()
    return jnp.split(p, offsets, axis=-1)


def axial_rope_tables(rows, dim):
    row = jnp.repeat(jnp.arange(rows), GRID_W).astype(F32)
    col = jnp.tile(jnp.arange(GRID_W), rows).astype(F32)
    n_freq = dim // 4
    inv_freq = ROPE_THETA ** (-jnp.arange(n_freq, dtype=F32) / n_freq)
    ang_r = row[:, None] * inv_freq[None, :]
    ang_c = col[:, None] * inv_freq[None, :]
    return (jnp.cos(ang_r), jnp.sin(ang_r), jnp.cos(ang_c), jnp.sin(ang_c))


def _rotate(x, cos, sin):
    n = x.shape[-1] // 2
    x1, x2 = x[..., :n], x[..., n:]
    cs, sn = cos[None, :, None, :], sin[None, :, None, :]
    return jnp.concatenate([x1 * cs - x2 * sn, x2 * cs + x1 * sn], axis=-1)


def apply_axial_rope(x, tabs):
    cos_r, sin_r, cos_c, sin_c = tabs
    xf = x.astype(F32)
    half = x.shape[-1] // 2
    out = jnp.concatenate([_rotate(xf[..., :half], cos_r, sin_r),
                           _rotate(xf[..., half:], cos_c, sin_c)], axis=-1)
    return out.astype(x.dtype)


def sweep_query_blocks(fn, qs):
    B, S = qs[0].shape[:2]
    nb = S // Q_BLOCK
    blocks = tuple(t.reshape(B, nb, Q_BLOCK, *t.shape[2:]).swapaxes(0, 1) for t in qs)
    out = lax.map(lambda bl: fn(*bl), blocks)
    return out.swapaxes(0, 1).reshape(B, S, *out.shape[3:])


def diff_attn_core(q1, q2, k1, k2, v, lam):
    scale = A_QK_DIM ** -0.5
    s1 = jnp.einsum('bqhd,bkhd->bhqk', q1.astype(F32), k1.astype(F32)) * scale
    s2 = jnp.einsum('bqhd,bkhd->bhqk', q2.astype(F32), k2.astype(F32)) * scale
    w = jax.nn.softmax(s1, axis=-1) - lam * jax.nn.softmax(s2, axis=-1)
    return jnp.einsum('bhqk,bkhd->bqhd', w, v.astype(F32)).astype(v.dtype)


def diff_attention_mixer(q, k, v, cq, ck, cv, lam_params, sub_gain, layer_idx, rope, need_ctx):
    B, S = q.shape[:2]
    Tc = cq.shape[1]

    def split_qk(t, pos):
        T = t.shape[1]
        t = t.reshape(B, T, A_HEADS * 2, A_QK_DIM)
        if pos is not None:
            t = apply_axial_rope(t, pos)
        t = t.reshape(B, T, A_HEADS, 2, A_QK_DIM)
        return t[..., 0, :], t[..., 1, :]

    q1, q2 = split_qk(q, rope)
    k1, k2 = split_qk(k, rope)
    cq1, cq2 = split_qk(cq, None)
    ck1, ck2 = split_qk(ck, None)
    vx = v.reshape(B, S, A_HEADS, A_V_DIM)
    vc = cv.reshape(B, Tc, A_HEADS, A_V_DIM)

    lam_init = 0.8 - 0.6 * math.exp(-0.3 * layer_idx)
    lp = lam_params.astype(F32)
    lam = jnp.exp(jnp.sum(lp[0] * lp[1])) - jnp.exp(jnp.sum(lp[2] * lp[3])) + lam_init

    k1_all = jnp.concatenate([ck1, k1], axis=1)
    k2_all = jnp.concatenate([ck2, k2], axis=1)
    v_all = jnp.concatenate([vc, vx], axis=1)
    o_x = sweep_query_blocks(lambda a, b: diff_attn_core(a, b, k1_all, k2_all, v_all, lam), (q1, q2))

    def finish(o):
        return (rmsnorm(o, sub_gain) * (1 - lam_init)).reshape(o.shape[0], o.shape[1], -1)

    out_c = finish(diff_attn_core(cq1, cq2, ck1, ck2, vc, lam)) if need_ctx else None
    return finish(o_x), out_c


def forget_gate(z, lb):
    sig = jax.nn.sigmoid(z)
    log_f = jnp.log(lb + (1 - lb) * sig)
    key = (1 - lb) * jax.nn.sigmoid(-z)
    return log_f, key


def gla_chunked(q, k, v, log_f, s0):
    B, T, H, _ = q.shape
    dv = v.shape[-1]
    n = T // CHUNK

    def to_chunks(t):
        return t.reshape(B, n, CHUNK, H, t.shape[-1]).transpose(1, 0, 3, 2, 4)

    incl = jnp.tril(jnp.ones((CHUNK, CHUNK), dtype=bool))[:, :, None]

    def step(state, inp):
        qc, kc, vc, gc = inp
        b = jnp.cumsum(gc, axis=2)
        o_inter = jnp.einsum('bhtd,bhde->bhte', qc * jnp.exp(b), state)
        rel = jnp.where(incl, b[:, :, :, None, :] - b[:, :, None, :, :], 0.0)
        decay = jnp.where(incl, jnp.exp(rel), 0.0)
        scores = jnp.einsum('bhtd,bhsd,bhtsd->bhts', qc, kc, decay)
        o_intra = jnp.einsum('bhts,bhse->bhte', scores, vc)
        b_end = b[:, :, -1:, :]
        new_state = (jnp.exp(b_end[:, :, 0, :])[..., None] * state
                     + jnp.einsum('bhsd,bhse->bhde', kc * jnp.exp(b_end - b), vc))
        return new_state, o_inter + o_intra

    s_end, o = lax.scan(step, s0, (to_chunks(q), to_chunks(k), to_chunks(v), to_chunks(log_f)))
    return o.transpose(1, 0, 3, 2, 4).reshape(B, T, H, dv), s_end


def gla_final_state(k, v, log_f):
    b = jnp.cumsum(log_f, axis=1)
    w = k * jnp.exp(b[:, -1:] - b)
    return jnp.einsum('bthd,bthe->bhde', w, v)


def hgrn2_mixer(q, f_fwd, f_bwd, i, g, cq, cf_fwd, cf_bwd, ci, cg, lb_fwd, lb_bwd, norm_gain, need_ctx):
    B, S = q.shape[:2]
    H, dk, dv = B_HEADS, B_KEY_DIM, B_VAL_DIM

    def heads(t, d):
        return t.reshape(t.shape[0], t.shape[1], H, d).astype(F32)

    def flip(t):
        return jnp.flip(t, axis=1)

    def ident(t):
        return t

    qx, ix, qc, ic = heads(q, dk), heads(i, dv), heads(cq, dk), heads(ci, dv)
    s0 = jnp.zeros((B, H, dk, dv), F32)
    o_x = jnp.zeros((B, S, H, dv), F32)
    o_c = jnp.zeros((B, cq.shape[1], H, dv), F32) if need_ctx else None
    for zx, zc, lb, order in ((f_fwd, cf_fwd, lb_fwd, ident), (f_bwd, cf_bwd, lb_bwd, flip)):
        lb = lb.reshape(H, dk)
        lfx, kx = forget_gate(heads(zx, dk), lb)
        lfc, kc = forget_gate(heads(zc, dk), lb)
        if need_ctx:
            oc, state = gla_chunked(order(qc), order(kc), order(ic), order(lfc), s0)
            o_c = o_c + order(oc)
        else:
            state = gla_final_state(order(kc), order(ic), order(lfc))
        ox, _ = gla_chunked(order(qx), order(kx), order(ix), order(lfx), state)
        o_x = o_x + order(ox)

    def finish(o, gate):
        T = o.shape[1]
        y = rmsnorm(o, norm_gain).reshape(B, T, H * dv) * jax.nn.silu(gate.astype(F32))
        return y.astype(gate.dtype)

    return finish(o_x, g), (finish(o_c, cg) if need_ctx else None)


def gqa_core(q, k, v):
    s = jnp.einsum('bqhgd,bkhd->bhgqk', q.astype(F32), k.astype(F32)) * HEAD_DIM ** -0.5
    p = jax.nn.softmax(s, axis=-1)
    return jnp.einsum('bhgqk,bkhd->bqhgd', p, v.astype(F32)).astype(v.dtype)


def gqa_mixer(q, k, v, cq, ck, cv, q_gain, k_gain, rope, need_ctx):
    B, S = q.shape[:2]
    G = C_Q_HEADS // C_KV_HEADS

    def prep(qt, kt, vt, pos):
        T = qt.shape[1]
        qh = rmsnorm(qt.reshape(B, T, C_Q_HEADS, HEAD_DIM), q_gain)
        kh = rmsnorm(kt.reshape(B, T, C_KV_HEADS, HEAD_DIM), k_gain)
        if pos is not None:
            qh = apply_axial_rope(qh, pos)
            kh = apply_axial_rope(kh, pos)
        return qh.reshape(B, T, C_KV_HEADS, G, HEAD_DIM), kh, vt.reshape(B, T, C_KV_HEADS, HEAD_DIM)

    qx, kx, vx = prep(q, k, v, rope)
    qc, kc, vc = prep(cq, ck, cv, None)
    k_all = jnp.concatenate([kc, kx], axis=1)
    v_all = jnp.concatenate([vc, vx], axis=1)
    out_x = sweep_query_blocks(lambda qb: gqa_core(qb, k_all, v_all), (qx,)).reshape(B, S, -1)
    out_c = gqa_core(qc, kc, vc).reshape(B, cq.shape[1], -1) if need_ctx else None
    return out_x, out_c


def fourier_mixer(u):
    B, T = u.shape[:2]
    grp = u.reshape(B, T, D_GROUPS, D_GROUP_DIM).astype(F32)
    y = jnp.fft.fftn(grp, axes=(1, 3), norm='ortho').real
    return y.reshape(B, T, D_GROUPS * D_GROUP_DIM).astype(u.dtype)


def swiglu(h, w_ffn_in, w_ffn_out):
    gate, up = jnp.split(h @ w_ffn_in, 2, axis=-1)
    return (jax.nn.silu(gate) * up) @ w_ffn_out


def hybrid_layer(x, ctx, c, c_ctx, w_mod, b_mod, norm1, w_in, diff_lambda, diff_norm,
                 lb_fwd, lb_bwd, hgrn_norm, q_norm, k_norm, w_out, norm2, w_ffn_in, w_ffn_out,
                 layer_idx, rope_a, rope_c, need_ctx):
    mod = jax.nn.silu(c) @ w_mod + b_mod
    mod_c = jax.nn.silu(c_ctx) @ w_mod + b_mod
    sh1, sc1, g1, sh2, sc2, g2 = jnp.split(mod[:, None, :], 6, axis=-1)
    csh1, csc1, cg1, csh2, csc2, cg2 = jnp.split(mod_c, 6, axis=-1)

    hx = modulate(rmsnorm(x, norm1), sh1, sc1)
    hc = modulate(rmsnorm(ctx, norm1), csh1, csc1)
    (xa_q, xa_k, xa_v, xb_q, xb_ff, xb_fb, xb_i, xb_g, xc_q, xc_k, xc_v, xd_u) = split_proj(hx @ w_in)
    (ca_q, ca_k, ca_v, cb_q, cb_ff, cb_fb, cb_i, cb_g, cc_q, cc_k, cc_v, cd_u) = split_proj(hc @ w_in)

    mA_x, mA_c = diff_attention_mixer(xa_q, xa_k, xa_v, ca_q, ca_k, ca_v, diff_lambda, diff_norm,
                                      layer_idx, rope_a, need_ctx)
    mB_x, mB_c = hgrn2_mixer(xb_q, xb_ff, xb_fb, xb_i, xb_g, cb_q, cb_ff, cb_fb, cb_i, cb_g,
                             lb_fwd, lb_bwd, hgrn_norm, need_ctx)
    mC_x, mC_c = gqa_mixer(xc_q, xc_k, xc_v, cc_q, cc_k, cc_v, q_norm, k_norm, rope_c, need_ctx)
    mD_x = fourier_mixer(xd_u)

    mix_x = jnp.concatenate([mA_x, mB_x, mC_x, mD_x], axis=-1)
    x = x + g1 * (mix_x @ w_out)
    x = x + g2 * swiglu(modulate(rmsnorm(x, norm2), sh2, sc2), w_ffn_in, w_ffn_out)

    if need_ctx:
        mix_c = jnp.concatenate([mA_c, mB_c, mC_c, fourier_mixer(cd_u)], axis=-1)
        ctx = ctx + cg1 * (mix_c @ w_out)
        ctx = ctx + cg2 * swiglu(modulate(rmsnorm(ctx, norm2), csh2, csc2), w_ffn_in, w_ffn_out)
    return x, ctx


def setup_inputs(seed: int = 0) -> dict:
    key = jax.random.key(seed)
    ks = jax.random.split(key, 19)
    D = D_MODEL
    nrm = jax.random.normal
    return {
        'x': nrm(ks[0], (BATCH, SEQ, D), F32),
        'c': nrm(ks[1], (BATCH, D), F32),
        'ctx': nrm(ks[2], (BATCH, CTX_LEN, D), F32),
        'c_ctx': nrm(ks[3], (D,), F32),
        'w_mod': nrm(ks[4], (DEPTH, D, 6 * D), F32) * (0.5 * D ** -0.5),
        'b_mod': nrm(ks[5], (DEPTH, 6 * D), F32) * 0.02,
        'norm1': 1.0 + 0.05 * nrm(ks[6], (DEPTH, D), F32),
        'w_in': nrm(ks[7], (DEPTH, D, IN_WIDTH), F32) * D ** -0.5,
        'diff_lambda': nrm(ks[8], (DEPTH, 4, A_QK_DIM), F32) * 0.1,
        'diff_norm': 1.0 + 0.05 * nrm(ks[9], (DEPTH, A_V_DIM), F32),
        'hgrn_lb_logits': nrm(ks[10], (2, DEPTH, B_HEADS * B_KEY_DIM), F32) * 0.5,
        'hgrn_norm': 1.0 + 0.05 * nrm(ks[11], (DEPTH, B_VAL_DIM), F32),
        'q_norm': 1.0 + 0.05 * nrm(ks[12], (DEPTH, HEAD_DIM), F32),
        'k_norm': 1.0 + 0.05 * nrm(ks[13], (DEPTH, HEAD_DIM), F32),
        'w_out': nrm(ks[14], (DEPTH, MIX_WIDTH, D), F32) * MIX_WIDTH ** -0.5,
        'norm2': 1.0 + 0.05 * nrm(ks[15], (DEPTH, D), F32),
        'w_ffn_in': nrm(ks[16], (DEPTH, D, 2 * FFN_HIDDEN), F32) * D ** -0.5,
        'w_ffn_out': nrm(ks[17], (DEPTH, FFN_HIDDEN, D), F32) * FFN_HIDDEN ** -0.5,
        'final_norm': 1.0 + 0.05 * nrm(ks[18], (D,), F32),
    }


def reference(x, c, ctx, c_ctx, w_mod, b_mod, norm1, w_in, diff_lambda, diff_norm,
              hgrn_lb_logits, hgrn_norm, q_norm, k_norm, w_out, norm2, w_ffn_in, w_ffn_out,
              final_norm):
    rows = x.shape[1] // GRID_W
    rope_a = axial_rope_tables(rows, A_QK_DIM)
    rope_c = axial_rope_tables(rows, HEAD_DIM)
    p = jax.nn.softmax(hgrn_lb_logits.astype(F32), axis=1)
    lower_bounds = jnp.cumsum(p, axis=1) - p[:, :1]
    for l in range(DEPTH):
        x, ctx = hybrid_layer(x, ctx, c, c_ctx, w_mod[l], b_mod[l], norm1[l], w_in[l],
                              diff_lambda[l], diff_norm[l], lower_bounds[0, l], lower_bounds[1, l],
                              hgrn_norm[l], q_norm[l], k_norm[l], w_out[l], norm2[l],
                              w_ffn_in[l], w_ffn_out[l], l, rope_a, rope_c, l < DEPTH - 1)
    return rmsnorm(x, final_norm)
```

```cpp
#include <hip/hip_runtime.h>
#include <hip/hip_cooperative_groups.h>
#include <cstdio>
#include <cstdint>
namespace cg = cooperative_groups;
namespace pg8 {
#define PG8_LAS __attribute__((address_space(3)))
typedef unsigned short bf16_t;
typedef short bf16x8 __attribute__((ext_vector_type(8)));
typedef float f32x4 __attribute__((ext_vector_type(4)));
typedef unsigned u32x4 __attribute__((ext_vector_type(4)));
constexpr int BM = 256, BK = 64, HALF = 128, HTB = HALF * BK * 2  , STAGE_BYTES = 8 * HTB, NXCD = 8, WGM = 4;

__host__ __device__ __forceinline__ int lds_byte(int r, int c) { const int st = (r >> 4) * 2 + (c >> 5), rr = r & 15, cc = c & 31, ob = rr * 64 + cc * 2; return st * 1024 + (ob ^ (((ob >> 9) & 1) << 5)); }
__host__ __device__ __forceinline__ void stage_rc(int b, int& R, int& C) { const int st = b / 1024, sb = b % 1024, swz = sb ^ (((sb >> 9) & 1) << 5); R = (st >> 1) * 16 + swz / 64; C = (st & 1) * 32 + (swz % 64) / 2; }
__host__ __device__ __forceinline__ int perm32(int rho) { const int n = rho >> 4, i = rho & 15; return 8 * (i >> 2) + 4 * n + (i & 3); }

struct Unit { int pm, pn; };
struct Gemm { const bf16_t* A; const bf16_t* Bt; int M, N, K; };

struct StaticOrder {
    int nM, nN, nwg, G, c;
    __host__ __device__ void init(int M, int N, int G_, int c_) { nM = M / BM; nN = N / BM; nwg = nM * nN; G = G_; c = c_; }
    __host__ __device__ bool next(int i, Unit& u) const {
        const long L = (long)i * G + c; if (L >= nwg) return false;
        int wgid = (int)L; { const int q = nwg / NXCD, r = nwg % NXCD, xcd = wgid % NXCD, off = wgid / NXCD; wgid = (xcd < r ? xcd * (q + 1) : r * (q + 1) + (xcd - r) * q) + off; }
        const int nig = WGM * nN, gid = wgid / nig, fm = gid * WGM, gsz = (nM - fm) < WGM ? (nM - fm) : WGM;
        u.pm = fm + ((wgid % nig) % gsz); u.pn = (wgid % nig) / gsz; return true;
    }
    __device__ __forceinline__ void a_ready(const Unit&) const {}
    __device__ __forceinline__ void done(const Unit&) const {}
};

__device__ __forceinline__ unsigned cvt_pk_bf16(float lo, float hi) { unsigned r; asm volatile("v_cvt_pk_bf16_f32 %0, %1, %2" : "=v"(r) : "v"(lo), "v"(hi)); return r; }
typedef float f32x2 __attribute__((ext_vector_type(2)));
__device__ __forceinline__ f32x2 gelu_pk(f32x2 v) {
    const f32x2 av = __builtin_elementwise_abs(v), d = av * 0.2316418882f + 1.0f;
    f32x2 t; t.x = __builtin_amdgcn_rcpf(d.x); t.y = __builtin_amdgcn_rcpf(d.y);
    f32x2 q = t * 0.5307027145f + (-0.7265760135f); q = q * t + 0.7107068705f; q = q * t + (-0.142248368f); q = q * t + 0.127414796f; q = q * t;
    const f32x2 s = (v * v) * (-0.72134752044f);
    f32x2 e; e.x = __builtin_amdgcn_exp2f(s.x); e.y = __builtin_amdgcn_exp2f(s.y);
    const f32x2 m = v * (q * e), r = v - m;
    f32x2 o; o.x = v.x < 0.f ? m.x : r.x; o.y = v.y < 0.f ? m.y : r.y; return o;
}

template <int ACT  > struct EpiBf16 {
    static constexpr bool PERM = true, AFTER_DRAIN = false; static_assert(ACT == 0 || ACT == 1, "EpiBf16: ACT is 0 (none) or 1 (gelu_pk)");
    bf16_t* O; int ldc; const float* bias; int split_cols; size_t split_stride; float scale0;
    __device__ __forceinline__ void operator()(const f32x4 (&acc)[2][2][4][2], const Unit& u, int wr, int wc, int fr, int fq) const {
        const int row0 = u.pm * BM + wr * 64 + fr; int colt = u.pn * BM; bf16_t* base = O;
        float sc = 1.f; if (split_cols) { const int t = colt / split_cols; base += (size_t)t * split_stride; colt -= t * split_cols; if (t == 0) sc = scale0; }
        const int col0 = colt + wc * 32 + 8 * fq, bcol0 = u.pn * BM + wc * 32 + 8 * fq;
        f32x4 bv[2][2];
#pragma unroll
        for (int bj = 0; bj < 2; ++bj)
#pragma unroll
            for (int n = 0; n < 2; ++n) bv[bj][n] = bias ? *(const f32x4*)(bias + bcol0 + bj * HALF + 4 * n) : (f32x4){0.f, 0.f, 0.f, 0.f};
#pragma unroll
        for (int ai = 0; ai < 2; ++ai)
#pragma unroll
            for (int m = 0; m < 4; ++m) { bf16_t* rowp = base + (size_t)(row0 + ai * HALF + m * 16) * ldc + col0;
#pragma unroll
                for (int bj = 0; bj < 2; ++bj) { f32x4 v0 = acc[ai][bj][m][0] + bv[bj][0], v1 = acc[ai][bj][m][1] + bv[bj][1];
                    if (ACT == 1) { f32x2 a = gelu_pk((f32x2){v0[0], v0[1]}), b = gelu_pk((f32x2){v0[2], v0[3]}), c = gelu_pk((f32x2){v1[0], v1[1]}), d = gelu_pk((f32x2){v1[2], v1[3]});
                        v0 = (f32x4){a.x, a.y, b.x, b.y}; v1 = (f32x4){c.x, c.y, d.x, d.y}; }
                    v0 = v0 * sc; v1 = v1 * sc; u32x4 w; w.x = cvt_pk_bf16(v0[0], v0[1]); w.y = cvt_pk_bf16(v0[2], v0[3]); w.z = cvt_pk_bf16(v1[0], v1[1]); w.w = cvt_pk_bf16(v1[2], v1[3]);
                    *(u32x4*)(rowp + bj * HALF) = w; } }
    }
};
template <class Epi, class Sched, bool ALIGN_EPI = false, bool SP2 = false>
__device__ __forceinline__ void gemm_phase(PG8_LAS unsigned char* lds, const Gemm g, const Sched& S, const Epi& E) {
    int tid_o = threadIdx.x; asm volatile("" : "+v"(tid_o));
    const int tid = tid_o, wid = __builtin_amdgcn_readfirstlane(tid >> 6), lane = tid & 63, wr = wid >> 2, wc = wid & 3, fr = lane & 15, fq = lane >> 4;
    const int K = g.K, nt = K / BK;
    unsigned voffA[2], voffB[2];
#pragma unroll
    for (int i = 0; i < 2; ++i) { int R, C; stage_rc(tid * 16 + i * 8192, R, C); const int Rb = Epi::PERM ? ((R & ~31) + perm32(R & 31)) : R;
        voffA[i] = (unsigned)(R * K + C) * 2u; voffB[i] = (unsigned)(Rb * K + C) * 2u; }
    const size_t kstep = (size_t)(BK * 2);
    const size_t hstep = (size_t)HALF * K * 2;
    const size_t tstep = 2 * hstep;
    const unsigned ldsw = (unsigned)wid * 1024u;
    const int aoff = lds_byte(wr * 64 + fr, fq * 8), boff = lds_byte(wc * 32 + fr, fq * 8);
#define PG8_SA(b, h) (((b) * 2 + (h)) * HTB)
#define PG8_SB(b, h) ((4 + (b) * 2 + (h)) * HTB)
#define PG8_STAGE(bufoff, gbase, voff) do { _Pragma("unroll") for (int _i = 0; _i < 2; ++_i) \
        __builtin_amdgcn_global_load_lds((const unsigned*)((const char*)(gbase) + (voff)[_i]), (PG8_LAS unsigned*)(lds + (bufoff) + ldsw + _i * 8192), 16, 0, 0); } while (0)
#define PG8_LDA(dst, b, h) do { _Pragma("unroll") for (int m = 0; m < 4; ++m) _Pragma("unroll") for (int k = 0; k < 2; ++k) dst[m][k] = *(const PG8_LAS bf16x8*)(lds + PG8_SA(b, h) + aoff + m * 2048 + k * 1024); } while (0)
#define PG8_LDB(dst, b, h) do { _Pragma("unroll") for (int n = 0; n < 2; ++n) _Pragma("unroll") for (int k = 0; k < 2; ++k) dst[n][k] = *(const PG8_LAS bf16x8*)(lds + PG8_SB(b, h) + boff + n * 2048 + k * 1024); } while (0)
#define PG8_MMA(ai, bj, At, Bt) do { __builtin_amdgcn_s_setprio(1); _Pragma("unroll") for (int m = 0; m < 4; ++m) _Pragma("unroll") for (int n = 0; n < 2; ++n) _Pragma("unroll") for (int k = 0; k < 2; ++k) \
        acc[ai][bj][m][n] = __builtin_amdgcn_mfma_f32_16x16x32_bf16(Bt[n][k], At[m][k], acc[ai][bj][m][n], 0, 0, 0); __builtin_amdgcn_s_setprio(0); } while (0)
#define PG8_WAIT_V(n) asm volatile("s_waitcnt vmcnt(" #n ")" ::: "memory")
#define PG8_WAIT_L(n) asm volatile("s_waitcnt lgkmcnt(" #n ")" ::: "memory")
#define PG8_BAR __builtin_amdgcn_s_barrier()
#define PG8_SCHED __builtin_amdgcn_sched_barrier(0)
    Unit cur, nxt; int ui = 0;
    if (!S.next(0, cur)) return;
    f32x4 acc[2][2][4][2];
#pragma unroll
    for (int a = 0; a < 2; ++a)
#pragma unroll
        for (int b = 0; b < 2; ++b)
#pragma unroll
            for (int m = 0; m < 4; ++m)
#pragma unroll
                for (int n = 0; n < 2; ++n) acc[a][b][m][n] = (f32x4){0.f, 0.f, 0.f, 0.f};
    bf16x8 At[4][2], B0[2][2], B1[2][2];
    const char* cA = (const char*)g.A + (size_t)cur.pm * tstep; const char* cB = (const char*)g.Bt + (size_t)cur.pn * tstep;
    S.a_ready(cur);
    if constexpr (SP2) {
        PG8_STAGE(PG8_SB(0, 0), cB, voffB); PG8_STAGE(PG8_SB(0, 1), cB + hstep, voffB); PG8_STAGE(PG8_SA(0, 0), cA, voffA); PG8_STAGE(PG8_SA(0, 1), cA + hstep, voffA);
        if (wr == 1) PG8_BAR;
        PG8_WAIT_V(2); PG8_BAR;
        PG8_STAGE(PG8_SB(1, 0), cB + kstep, voffB); PG8_STAGE(PG8_SA(1, 0), cA + kstep, voffA); PG8_STAGE(PG8_SB(1, 1), cB + hstep + kstep, voffB);
        PG8_WAIT_V(6); PG8_BAR;
    } else {
        PG8_STAGE(PG8_SB(0, 0), cB, voffB); PG8_STAGE(PG8_SA(0, 0), cA, voffA); PG8_STAGE(PG8_SB(0, 1), cB + hstep, voffB); PG8_STAGE(PG8_SA(0, 1), cA + hstep, voffA);
        if (wr == 1) PG8_BAR;
        PG8_WAIT_V(4); PG8_BAR;
        PG8_STAGE(PG8_SB(1, 0), cB + kstep, voffB); PG8_STAGE(PG8_SA(1, 0), cA + kstep, voffA); PG8_STAGE(PG8_SB(1, 1), cB + hstep + kstep, voffB);
        PG8_WAIT_V(6); PG8_BAR;
    }
    for (;;) {
        const bool has_next = S.next(ui + 1, nxt);
        const char* nA = has_next ? (const char*)g.A + (size_t)nxt.pm * tstep : cA; const char* nB = has_next ? (const char*)g.Bt + (size_t)nxt.pn * tstep : cB;
        for (int t = 0; t < nt; t += 2) {
            const bool last = (t == nt - 2);
            const char* a1 = cA + (size_t)(t + 1) * kstep;
            const char* a2 = last ? nA : cA + (size_t)(t + 2) * kstep; const char* b2 = last ? nB : cB + (size_t)(t + 2) * kstep;
            const char* a3 = a2 + kstep; const char* b3 = b2 + kstep;
            if (last && has_next) S.a_ready(nxt);
            if constexpr (SP2) {
            PG8_LDB(B0, 0, 0); PG8_LDB(B1, 0, 1); PG8_SCHED; PG8_LDA(At, 0, 0); PG8_STAGE(PG8_SA(1, 1), a1 + hstep, voffA);
            PG8_WAIT_V(8); PG8_WAIT_L(0); PG8_BAR; PG8_MMA(0, 0, At, B0); PG8_MMA(0, 1, At, B1); PG8_BAR; PG8_SCHED;
            PG8_LDA(At, 0, 1); PG8_STAGE(PG8_SB(0, 0), b2, voffB); PG8_STAGE(PG8_SB(0, 1), b2 + hstep, voffB); PG8_STAGE(PG8_SA(0, 0), a2, voffA);
            PG8_WAIT_V(8); PG8_WAIT_L(0); PG8_BAR; PG8_MMA(1, 0, At, B0); PG8_MMA(1, 1, At, B1); PG8_BAR; PG8_SCHED;
            PG8_LDB(B0, 1, 0); PG8_LDB(B1, 1, 1); PG8_SCHED; PG8_LDA(At, 1, 0); PG8_STAGE(PG8_SA(0, 1), a2 + hstep, voffA);
            PG8_WAIT_V(8); PG8_WAIT_L(0); PG8_BAR; PG8_MMA(0, 0, At, B0); PG8_MMA(0, 1, At, B1); PG8_BAR; PG8_SCHED;
            PG8_LDA(At, 1, 1); PG8_STAGE(PG8_SB(1, 0), b3, voffB); PG8_STAGE(PG8_SB(1, 1), b3 + hstep, voffB); PG8_STAGE(PG8_SA(1, 0), a3, voffA);
            PG8_WAIT_V(8); PG8_WAIT_L(0); PG8_BAR; PG8_MMA(1, 0, At, B0); PG8_MMA(1, 1, At, B1); PG8_BAR; PG8_SCHED;
            } else {
            PG8_LDB(B0, 0, 0); PG8_SCHED; PG8_LDA(At, 0, 0); PG8_STAGE(PG8_SA(1, 1), a1 + hstep, voffA);
            PG8_WAIT_L(8); PG8_BAR; PG8_WAIT_L(0); PG8_MMA(0, 0, At, B0); PG8_BAR; PG8_SCHED;
            PG8_LDB(B1, 0, 1); PG8_STAGE(PG8_SB(0, 0), b2, voffB);
            PG8_BAR; PG8_WAIT_L(0); PG8_MMA(0, 1, At, B1); PG8_BAR;
            PG8_LDA(At, 0, 1); PG8_STAGE(PG8_SA(0, 0), a2, voffA);
            PG8_BAR; PG8_WAIT_L(0); PG8_MMA(1, 0, At, B0); PG8_BAR; PG8_SCHED;
            PG8_STAGE(PG8_SB(0, 1), b2 + hstep, voffB);
            PG8_WAIT_V(6); PG8_BAR; PG8_MMA(1, 1, At, B1); PG8_BAR;
            PG8_LDB(B0, 1, 0); PG8_SCHED; PG8_LDA(At, 1, 0); PG8_STAGE(PG8_SA(0, 1), a2 + hstep, voffA);
            PG8_WAIT_L(8); PG8_BAR; PG8_WAIT_L(0); PG8_MMA(0, 0, At, B0); PG8_BAR; PG8_SCHED;
            PG8_LDB(B1, 1, 1); PG8_STAGE(PG8_SB(1, 0), b3, voffB);
            PG8_BAR; PG8_WAIT_L(0); PG8_MMA(0, 1, At, B1); PG8_BAR;
            PG8_LDA(At, 1, 1); PG8_STAGE(PG8_SA(1, 0), a3, voffA);
            PG8_BAR; PG8_WAIT_L(0); PG8_MMA(1, 0, At, B0); PG8_BAR; PG8_SCHED;
            PG8_STAGE(PG8_SB(1, 1), b3 + hstep, voffB);
            PG8_WAIT_V(6); PG8_BAR; PG8_MMA(1, 1, At, B1); PG8_BAR;
            }
        }
        if constexpr (ALIGN_EPI) { if (wr == 0) PG8_BAR; }
        if constexpr (!Epi::AFTER_DRAIN) { E(acc, cur, wr, wc, fr, fq); S.done(cur); }
        if (!has_next) break;
#pragma unroll
        for (int a = 0; a < 2; ++a)
#pragma unroll
            for (int b = 0; b < 2; ++b)
#pragma unroll
                for (int m = 0; m < 4; ++m)
#pragma unroll
                    for (int n = 0; n < 2; ++n) acc[a][b][m][n] = (f32x4){0.f, 0.f, 0.f, 0.f};
        cur = nxt; cA = nA; cB = nB; ++ui;
        if constexpr (ALIGN_EPI) { if (wr == 1) PG8_BAR; }
    }
    PG8_WAIT_V(0);
    if constexpr (!ALIGN_EPI) { if (wr == 0) PG8_BAR; }
    PG8_BAR;
    if constexpr (Epi::AFTER_DRAIN) { E.fused(acc, cur, wr, wc, fr, fq, lds, wid, lane); S.done(cur); }
#undef PG8_SA
#undef PG8_SB
#undef PG8_STAGE
#undef PG8_LDA
#undef PG8_LDB
#undef PG8_MMA
#undef PG8_WAIT_V
#undef PG8_WAIT_L
#undef PG8_BAR
#undef PG8_SCHED
}
}

#define LAS __attribute__((address_space(3)))
typedef unsigned short bf16_t;
typedef short bf16x8 __attribute__((ext_vector_type(8)));
typedef float f32x4 __attribute__((ext_vector_type(4)));
typedef float f32x16 __attribute__((ext_vector_type(16)));
typedef unsigned u32x4 __attribute__((ext_vector_type(4)));
typedef unsigned u32x2 __attribute__((ext_vector_type(2)));

constexpr int DM = 1024, NBATCH = 16, SEQ = 2048, CTX = 256, TT = SEQ + CTX  , ROWS = NBATCH * TT  ;
constexpr int INW = 2816, FFH = 2816, DEPTH = 4, MODW = 6 * DM;
constexpr float RMS_EPS = 1e-6f;
constexpr float LOG2E = 1.4426950408889634f;
constexpr int PA_Q = 0, PA_K = 256, PA_V = 512, PB_Q = 768, PB_FF = 1024, PB_FB = 1280, PB_I = 1536, PB_G = 1792, PC_Q = 2048, PC_K = 2304, PC_V = 2432, PD_U = 2560;

constexpr size_t MiB = 1u << 20;
constexpr size_t WS_CTL = 0;
constexpr size_t WS_MOD = 1 * MiB;
constexpr size_t WS_W = 4 * MiB, WS_WBUF = 24 * MiB;
constexpr size_t WS_W_OUT = WS_W + (size_t)INW * DM * 2, WS_W_FI = WS_W_OUT + (size_t)DM * DM * 2, WS_W_FO = WS_W_FI + (size_t)2 * FFH * DM * 2;
constexpr size_t WS_FMAT = 52 * MiB;
constexpr size_t WS_FC = 68 * MiB;
constexpr size_t WS_XC = 69 * MiB;
constexpr size_t WS_H = 85 * MiB;
constexpr size_t WS_PROJ = 157 * MiB;
constexpr size_t WS_VTA = 355 * MiB;
constexpr size_t WS_VTC = 373 * MiB;
constexpr size_t WS_ZT = 382 * MiB;
constexpr size_t WS_ZCT = 414 * MiB;
constexpr size_t WS_ODIR = 418 * MiB;
constexpr size_t WS_END = 490 * MiB;
static_assert(WS_W_FO + (size_t)DM * FFH * 2 <= WS_W + WS_WBUF && WS_W + 2 * WS_WBUF <= WS_FMAT, "weights fit");
constexpr int CW_QUEUE = 8192;
constexpr int CW_LAM = 1024;
constexpr int CW_LB = 2048;
constexpr int CW_BAR = 4096, XCD_BAR_WORDS_C = 3456;

constexpr int LDS_RING = 131072, LDS_MISC = LDS_RING, LDS_BYTES = 147456;

struct Params {
    const float *x, *c, *ctx, *c_ctx, *w_mod, *b_mod, *norm1, *w_in, *diff_lambda, *diff_norm, *lb_logits, *hgrn_norm, *q_norm, *k_norm, *w_out, *norm2, *w_ffn_in, *w_ffn_out, *final_norm;
    float* out; unsigned char* ws;
};

__device__ __forceinline__ int opaque_tid() { int t = threadIdx.x; asm volatile("" : "+v"(t)); return t; }
__device__ __forceinline__ unsigned f2bf(float f) { unsigned u = __builtin_bit_cast(unsigned, f); return (u + 0x7fffu + ((u >> 16) & 1u)) >> 16; }
typedef float f32x2_t __attribute__((ext_vector_type(2))); typedef __bf16 bf16x2_t __attribute__((ext_vector_type(2)));
__device__ __forceinline__ unsigned pk2(float lo, float hi) { f32x2_t v = {lo, hi}; bf16x2_t b = __builtin_convertvector(v, bf16x2_t); return __builtin_bit_cast(unsigned, b); }
__device__ __forceinline__ float bf2f(unsigned h) { return __builtin_bit_cast(float, h << 16); }
__device__ __forceinline__ float bflo(unsigned w) { return __builtin_bit_cast(float, w << 16); }
__device__ __forceinline__ float bfhi(unsigned w) { return __builtin_bit_cast(float, w & 0xffff0000u); }
__device__ __forceinline__ float shx(float v, int o, int lane) { return __builtin_bit_cast(float, __builtin_amdgcn_ds_bpermute((lane ^ o) << 2, __builtin_bit_cast(int, v))); }
__device__ __forceinline__ float wave_sum(float v, int lane) {
#pragma unroll
    for (int o = 1; o < 64; o <<= 1) v += shx(v, o, lane);
    return v;
}
__device__ __forceinline__ float fast_exp2(float x) { return __builtin_amdgcn_exp2f(x); }
__device__ __forceinline__ float sigmoidf_(float z) { return __builtin_amdgcn_rcpf(1.0f + fast_exp2(-z * LOG2E)); }

__device__ __forceinline__ float* xrow_ptr(const Params& P, int r) {
    const int b = r / TT, t = r - b * TT;
    return (t < CTX) ? (float*)(P.ws + WS_XC) + ((size_t)b * CTX + t) * DM : P.out + ((size_t)b * SEQ + (t - CTX)) * DM;
}

struct EpiResid {
    static constexpr bool PERM = false, AFTER_DRAIN = false;
    float* out; float* xc; const float* gate;
    __device__ __forceinline__ void operator()(const pg8::f32x4 (&acc)[2][2][4][2], const pg8::Unit& u, int wr, int wc, int fr, int fq) const {
        const int b = u.pm / 9, j = u.pm - b * 9;
        float* base = (j == 0) ? xc + (size_t)b * CTX * DM : out + ((size_t)b * SEQ + (size_t)(j - 1) * 256) * DM;
        const float* g = gate + (size_t)((j == 0) ? 16 : b) * MODW;
        const int col0 = u.pn * 256 + wc * 32 + 4 * fq;
        pg8::f32x4 gv[2][2];
#pragma unroll
        for (int bj = 0; bj < 2; ++bj)
#pragma unroll
            for (int n = 0; n < 2; ++n) gv[bj][n] = *(const pg8::f32x4*)(g + col0 + bj * 128 + n * 16);
#pragma unroll
        for (int ai = 0; ai < 2; ++ai)
#pragma unroll
            for (int m = 0; m < 4; ++m) {
                float* rowp = base + (size_t)(ai * 128 + wr * 64 + m * 16 + fr) * DM + col0;
#pragma unroll
                for (int bj = 0; bj < 2; ++bj)
#pragma unroll
                    for (int n = 0; n < 2; ++n) {
                        pg8::f32x4* p = (pg8::f32x4*)(rowp + bj * 128 + n * 16);
                        pg8::f32x4 xv = *p; xv = xv + gv[bj][n] * acc[ai][bj][m][n]; *p = xv;
                    }
                if (m & 1) asm volatile("" ::: "memory");
            }
    }
};
struct EpiSwiGLU {
    static constexpr bool PERM = true, AFTER_DRAIN = false;
    bf16_t* O;
    __device__ __forceinline__ void operator()(const pg8::f32x4 (&acc)[2][2][4][2], const pg8::Unit& u, int wr, int wc, int fr, int fq) const {
        const int col0 = u.pn * 128 + wc * 32 + 8 * fq;
#pragma unroll
        for (int ai = 0; ai < 2; ++ai)
#pragma unroll
            for (int m = 0; m < 4; ++m) {
                bf16_t* rowp = O + (size_t)(u.pm * 256 + ai * 128 + wr * 64 + m * 16 + fr) * FFH + col0;
                float v[8];
#pragma unroll
                for (int n = 0; n < 2; ++n)
#pragma unroll
                    for (int e = 0; e < 4; ++e) { const float g = acc[ai][0][m][n][e], up = acc[ai][1][m][n][e]; v[n * 4 + e] = g * sigmoidf_(g) * up; }
                u32x4 w; w.x = pk2(v[0], v[1]); w.y = pk2(v[2], v[3]); w.z = pk2(v[4], v[5]); w.w = pk2(v[6], v[7]);
                *(u32x4*)rowp = w;
            }
    }
};
struct OneUnit {
    int pm, pn;
    __device__ bool next(int i, pg8::Unit& u) const { if (i != 0) return false; u.pm = pm; u.pn = pn; return true; }
    __device__ __forceinline__ void a_ready(const pg8::Unit&) const {}
    __device__ __forceinline__ void done(const pg8::Unit&) const {}
};
struct LatOrder {
    pg8::StaticOrder S;
    __device__ void init(int N, int G, int c) { S.init(NBATCH * SEQ, N, G, c); }
    __device__ bool next(int i, pg8::Unit& u) const { if (!S.next(i, u)) return false; u.pm = (u.pm >> 3) * 9 + 1 + (u.pm & 7); return true; }
    __device__ __forceinline__ void a_ready(const pg8::Unit&) const {}
    __device__ __forceinline__ void done(const pg8::Unit&) const {}
};

__device__ __forceinline__ void phase_init(const Params& P, unsigned char* lds) {
    const int tid = opaque_tid(), lane = tid & 63, wave = tid >> 6, G = gridDim.x, blk = blockIdx.x;
    unsigned* ctl = (unsigned*)(P.ws + WS_CTL);
    if (blk == 0) { if (tid < 8 * DEPTH) ctl[CW_QUEUE + 64 * tid] = 0u; for (int i = tid; i < XCD_BAR_WORDS_C; i += 512) ctl[CW_BAR + i] = 0u; }
    if (blk == 1 % G) {
        float* lbv = (float*)ctl + CW_LB;
        { const int dir = tid >> 8, j = tid & 255; float z[DEPTH], mx = -1e30f;
#pragma unroll
          for (int l = 0; l < DEPTH; ++l) { z[l] = P.lb_logits[((size_t)dir * DEPTH + l) * 256 + j]; mx = fmaxf(mx, z[l]); }
          float s = 0.f;
#pragma unroll
          for (int l = 0; l < DEPTH; ++l) { z[l] = __expf(z[l] - mx); s += z[l]; }
          float cum = 0.f; const float inv = 1.0f / s;
#pragma unroll
          for (int l = 0; l < DEPTH; ++l) { if (l > 0) cum += z[l] * inv; lbv[((size_t)dir * DEPTH + l) * 256 + j] = cum; } }
        if (wave < DEPTH) { const int l = wave; const float* lp = P.diff_lambda + (size_t)l * 128;
            float a = (lane < 32) ? lp[lane] * lp[32 + lane] : 0.f, b2 = (lane < 32) ? lp[64 + lane] * lp[96 + lane] : 0.f;
            a = wave_sum(a, lane); b2 = wave_sum(b2, lane);
            const float lam_init = 0.8f - 0.6f * expf(-0.3f * (float)l);
            if (lane == 0) { ((float*)ctl)[CW_LAM + l] = expf(a) - expf(b2) + lam_init; ((float*)ctl)[CW_LAM + 8 + l] = 1.0f - lam_init; } }
    }
    float* sc = (float*)lds;
    for (int i = tid; i < 17 * DM; i += 512) { const int bb = i >> 10, k = i & 1023; const float v = (bb < 16) ? P.c[(size_t)bb * DM + k] : P.c_ctx[k]; sc[i] = v * sigmoidf_(v); }
    __syncthreads();
    float* red = (float*)(lds + 17 * DM * 4);
    float* mod = (float*)(P.ws + WS_MOD);
    for (int it = blk; it < DEPTH * (MODW / 64); it += G) {
        const int l = it / (MODW / 64), n0 = (it % (MODW / 64)) * 64;
        const float* W = P.w_mod + (size_t)l * DM * MODW + n0 + lane;
        float acc[17];
#pragma unroll
        for (int bb = 0; bb < 17; ++bb) acc[bb] = 0.f;
        for (int k = wave * 128; k < wave * 128 + 128; k += 4) {
            const float w0 = W[(size_t)k * MODW], w1 = W[(size_t)(k + 1) * MODW], w2 = W[(size_t)(k + 2) * MODW], w3 = W[(size_t)(k + 3) * MODW];
#pragma unroll
            for (int bb = 0; bb < 17; ++bb) { const f32x4 s4 = *(const f32x4*)(sc + bb * DM + k); acc[bb] += s4.x * w0 + s4.y * w1 + s4.z * w2 + s4.w * w3; }
        }
#pragma unroll
        for (int bb = 0; bb < 17; ++bb) red[(wave * 17 + bb) * 64 + lane] = acc[bb];
        __syncthreads();
        for (int i = tid; i < 17 * 64; i += 512) { const int bb = i >> 6, n = i & 63; float s = 0.f;
#pragma unroll
            for (int w = 0; w < 8; ++w) s += red[(w * 17 + bb) * 64 + n];
            mod[((size_t)l * 17 + bb) * MODW + n0 + n] = s + P.b_mod[(size_t)l * MODW + n0 + n]; }
        __syncthreads();
    }
    {
        bf16_t* F = (bf16_t*)(P.ws + WS_FMAT);
        const float sc1 = 0.022097086912079608f;
        for (int i = blk * 512 + tid; i < 2048 * 2048 / 8; i += G * 512) {
            const int tp = i >> 8, k0 = (i & 255) * 8; float v[8];
#pragma unroll
            for (int j = 0; j < 8; ++j) { const int k = k0 + j; const int kk = k & 1023; const float rev = (float)((tp * kk) & 2047) * (1.0f / 2048.0f);
                v[j] = (k < 1024) ? __builtin_amdgcn_cosf(rev) * sc1 : ((k == 1024) ? ((tp & 1) ? -sc1 : sc1) : -__builtin_amdgcn_sinf(rev) * sc1); }
            u32x4 w; w.x = pk2(v[0], v[1]); w.y = pk2(v[2], v[3]); w.z = pk2(v[4], v[5]); w.w = pk2(v[6], v[7]);
            *(u32x4*)(F + (size_t)i * 8) = w;
        }
        bf16_t* Fc = (bf16_t*)(P.ws + WS_FC);
        for (int i = blk * 512 + tid; i < 256 * 512 / 8; i += G * 512) {
            const int tp = i >> 6, k0 = (i & 63) * 8; float v[8];
#pragma unroll
            for (int j = 0; j < 8; ++j) { const int k = k0 + j; const int kk = k & 255; const float rev = (float)((tp * kk) & 255) * (1.0f / 256.0f);
                v[j] = (k < 256) ? __builtin_amdgcn_cosf(rev) * 0.0625f : -__builtin_amdgcn_sinf(rev) * 0.0625f; }
            u32x4 w; w.x = pk2(v[0], v[1]); w.y = pk2(v[2], v[3]); w.z = pk2(v[4], v[5]); w.w = pk2(v[6], v[7]);
            *(u32x4*)(Fc + (size_t)i * 8) = w;
        }
    }
}

__device__ __forceinline__ void transpose_item(const float* W, int K, int N, bf16_t* WT, int mode, float* scr, int item, int lane) {
    const int nblk = N / 32, kb = item / nblk, nb = item % nblk, k0 = 64 * kb, n0 = 32 * nb;
    int r0 = n0;
    if (mode == 1) { r0 = (n0 < FFH) ? (n0 / 128) * 256 + (n0 % 128) : ((n0 - FFH) / 128) * 256 + 128 + ((n0 - FFH) % 128); }
#pragma unroll 8
    for (int i = 0; i < 32; ++i) { const int kk = 2 * i + (lane >> 5); scr[kk * 33 + (lane & 31)] = W[(size_t)(k0 + kk) * N + n0 + (lane & 31)]; }
    asm volatile("s_waitcnt lgkmcnt(0)" ::: "memory");
    const int c = lane & 7;
#pragma unroll
    for (int j = 0; j < 4; ++j) { const int n = (lane >> 3) + 8 * j; const float* s = scr + (8 * c) * 33 + n;
        u32x4 o; o.x = pk2(s[0 * 33], s[1 * 33]); o.y = pk2(s[2 * 33], s[3 * 33]); o.z = pk2(s[4 * 33], s[5 * 33]); o.w = pk2(s[6 * 33], s[7 * 33]);
        *(u32x4*)(WT + (size_t)(r0 + n) * K + k0 + 8 * c) = o; }
    asm volatile("s_waitcnt lgkmcnt(0)" ::: "memory");
}
__device__ __forceinline__ void convert_weights(const Params& P, int l, unsigned char* lds, int blk0) {
    const int tid = opaque_tid(), lane = tid & 63, wave = tid >> 6;
    if ((int)blockIdx.x < blk0) return;
    float* scr = (float*)(lds + wave * 16384);
    const int gw = ((int)blockIdx.x - blk0) * 8 + wave, NGW = ((int)gridDim.x - blk0) * 8;
    unsigned char* wb = P.ws + (size_t)(l & 1) * WS_WBUF;
    constexpr int I_IN = (DM / 64) * (INW / 32), I_OUT = (DM / 64) * (DM / 32), I_FI = (DM / 64) * (2 * FFH / 32), I_FO = (FFH / 64) * (DM / 32);
    for (int it = gw; it < I_IN + I_OUT + I_FI + I_FO; it += NGW) {
        int r = it;
        if (r < I_IN) { transpose_item(P.w_in + (size_t)l * DM * INW, DM, INW, (bf16_t*)(wb + WS_W), 0, scr, r, lane); continue; } r -= I_IN;
        if (r < I_OUT) { transpose_item(P.w_out + (size_t)l * DM * DM, DM, DM, (bf16_t*)(wb + WS_W_OUT), 0, scr, r, lane); continue; } r -= I_OUT;
        if (r < I_FI) { transpose_item(P.w_ffn_in + (size_t)l * DM * 2 * FFH, DM, 2 * FFH, (bf16_t*)(wb + WS_W_FI), 1, scr, r, lane); continue; } r -= I_FI;
        transpose_item(P.w_ffn_out + (size_t)l * FFH * DM, FFH, DM, (bf16_t*)(wb + WS_W_FO), 0, scr, r, lane);
    }
}

__device__ __forceinline__ void phase_norm(const Params& P, int l, int which, bool first) {
    const int tid = opaque_tid(), lane = tid & 63, wave = tid >> 6;
    const int gw = blockIdx.x * 8 + wave, NGW = gridDim.x * 8;
    const float* gain = (which == 0 ? P.norm1 : P.norm2) + (size_t)l * DM;
    const float* mod = (const float*)(P.ws + WS_MOD) + (size_t)l * 17 * MODW + (which == 0 ? 0 : 3 * DM);
    bf16_t* H = (bf16_t*)(P.ws + WS_H);
    for (int r = gw; r < ROWS; r += NGW) {
        const int b = r / TT, t = r - b * TT; const int bb = (t < CTX) ? 16 : b;
        float* xr = xrow_ptr(P, r);
        const float* src = first ? ((t < CTX) ? P.ctx + ((size_t)b * CTX + t) * DM : P.x + ((size_t)b * SEQ + (t - CTX)) * DM) : xr;
        f32x4 v[4]; float s2 = 0.f;
#pragma unroll
        for (int j = 0; j < 4; ++j) { v[j] = *((const f32x4*)src + lane + 64 * j); s2 += (v[j].x * v[j].x + v[j].y * v[j].y) + (v[j].z * v[j].z + v[j].w * v[j].w); }
        if (first) {
#pragma unroll
            for (int j = 0; j < 4; ++j) *((f32x4*)xr + lane + 64 * j) = v[j];
        }
        const float rstd = 1.0f / sqrtf(wave_sum(s2, lane) * (1.0f / DM) + RMS_EPS);
        const float* mrow = mod + (size_t)bb * MODW;
#pragma unroll
        for (int j = 0; j < 4; ++j) {
            const int c0 = 4 * (lane + 64 * j);
            const f32x4 g = *(const f32x4*)(gain + c0), sh = *(const f32x4*)(mrow + c0), scl = *(const f32x4*)(mrow + DM + c0);
            const f32x4 y = v[j] * rstd * g * (scl + 1.0f) + sh;
            u32x2 w; w.x = pk2(y.x, y.y); w.y = pk2(y.z, y.w);
            *(u32x2*)(H + (size_t)r * DM + c0) = w;
        }
    }
}
__device__ __forceinline__ void phase_final(const Params& P) {
    const int tid = opaque_tid(), lane = tid & 63, wave = tid >> 6;
    const int gw = blockIdx.x * 8 + wave, NGW = gridDim.x * 8;
    for (int r = gw; r < NBATCH * SEQ; r += NGW) {
        float* xr = P.out + (size_t)r * DM;
        f32x4 v[4]; float s2 = 0.f;
#pragma unroll
        for (int j = 0; j < 4; ++j) { v[j] = *((const f32x4*)xr + lane + 64 * j); s2 += (v[j].x * v[j].x + v[j].y * v[j].y) + (v[j].z * v[j].z + v[j].w * v[j].w); }
        const float rstd = 1.0f / sqrtf(wave_sum(s2, lane) * (1.0f / DM) + RMS_EPS);
#pragma unroll
        for (int j = 0; j < 4; ++j) { const f32x4 g = *((const f32x4*)P.final_norm + lane + 64 * j); *((f32x4*)xr + lane + 64 * j) = v[j] * rstd * g; }
    }
}

template <int NF> __device__ __forceinline__ void rope_half(float* v, int pos) {
#pragma unroll
    for (int i = 0; i < NF; ++i) {
        const float inv_freq = exp2f(-13.287712379549449f * (float)i / (float)NF);
        const float rev = (float)pos * inv_freq * 0.15915494309189535f;
        const float cs = __builtin_amdgcn_cosf(rev), sn = __builtin_amdgcn_sinf(rev);
        const float x1 = v[i], x2 = v[NF + i];
        v[i] = x1 * cs - x2 * sn; v[NF + i] = x2 * cs + x1 * sn;
    }
}
__device__ __forceinline__ void phase_prep(const Params& P, int l, unsigned char* lds) {
    const int G = gridDim.x;
    bf16_t* proj = (bf16_t*)(P.ws + WS_PROJ);
    for (int item = blockIdx.x; item < ROWS / 64 + NBATCH * 20; item += G) {
        const int tid = opaque_tid();
        const int type = item >= ROWS / 64;
        int r0, b, t0;
        if (!type) { r0 = item * 64; b = r0 / TT; t0 = r0 - b * TT; }
        else { const int idx = item - ROWS / 64; b = idx / 20; const int jb = idx - b * 20; t0 = (jb < 4) ? 64 * jb : CTX + 64 * (jb - 4); r0 = b * TT + t0; }
        const bool is_ctx = t0 < CTX;
        if (type == 0) {
#pragma unroll 1
            for (int rep = 0; rep < 2; ++rep) {
                const int id = tid + 512 * rep, tok = id >> 4, vv = id & 15; const bool isq = vv < 8;
                if (is_ctx && !isq) continue;
                bf16_t* p = proj + (size_t)(r0 + tok) * INW + (isq ? PA_Q + 32 * vv : PA_K + 32 * (vv - 8));
                u32x4 w[4]; float v[32];
#pragma unroll
                for (int j = 0; j < 4; ++j) { w[j] = *((const u32x4*)p + j);
                    v[8 * j + 0] = bflo(w[j].x); v[8 * j + 1] = bfhi(w[j].x); v[8 * j + 2] = bflo(w[j].y); v[8 * j + 3] = bfhi(w[j].y);
                    v[8 * j + 4] = bflo(w[j].z); v[8 * j + 5] = bfhi(w[j].z); v[8 * j + 6] = bflo(w[j].w); v[8 * j + 7] = bfhi(w[j].w); }
                if (!is_ctx) { const int tl = t0 - CTX + tok; rope_half<8>(v, tl >> 6); rope_half<8>(v + 16, tl & 63); }
                const float sc = isq ? 0.17677669529663687f * LOG2E : 1.0f;
#pragma unroll
                for (int j = 0; j < 4; ++j) { u32x4 o; o.x = pk2(v[8 * j] * sc, v[8 * j + 1] * sc); o.y = pk2(v[8 * j + 2] * sc, v[8 * j + 3] * sc); o.z = pk2(v[8 * j + 4] * sc, v[8 * j + 5] * sc); o.w = pk2(v[8 * j + 6] * sc, v[8 * j + 7] * sc);
                    *((u32x4*)p + j) = o; }
            }
            if (tid < 384) {
                const int tok = tid / 6, vv = tid - tok * 6; const bool isq = vv < 4;
                bf16_t* p = proj + (size_t)(r0 + tok) * INW + (isq ? PC_Q + 64 * vv : PC_K + 64 * (vv - 4));
                const float* gain = (isq ? P.q_norm : P.k_norm) + (size_t)l * 64;
                float v[64]; float s2 = 0.f;
#pragma unroll
                for (int j = 0; j < 8; ++j) { const u32x4 w = *((const u32x4*)p + j);
                    v[8 * j + 0] = bflo(w.x); v[8 * j + 1] = bfhi(w.x); v[8 * j + 2] = bflo(w.y); v[8 * j + 3] = bfhi(w.y);
                    v[8 * j + 4] = bflo(w.z); v[8 * j + 5] = bfhi(w.z); v[8 * j + 6] = bflo(w.w); v[8 * j + 7] = bfhi(w.w); }
#pragma unroll
                for (int j = 0; j < 64; ++j) s2 += v[j] * v[j];
                const float rstd = 1.0f / sqrtf(s2 * (1.0f / 64.0f) + RMS_EPS);
#pragma unroll
                for (int j = 0; j < 64; ++j) v[j] = v[j] * rstd * gain[j];
                if (!is_ctx) { const int tl = t0 - CTX + tok; rope_half<16>(v, tl >> 6); rope_half<16>(v + 32, tl & 63); }
                const float sc = isq ? 0.125f * LOG2E : 1.0f;
#pragma unroll
                for (int j = 0; j < 8; ++j) { u32x4 o; o.x = pk2(v[8 * j] * sc, v[8 * j + 1] * sc); o.y = pk2(v[8 * j + 2] * sc, v[8 * j + 3] * sc); o.z = pk2(v[8 * j + 4] * sc, v[8 * j + 5] * sc); o.w = pk2(v[8 * j + 6] * sc, v[8 * j + 7] * sc);
                    *((u32x4*)p + j) = o; }
            }
#pragma unroll 1
            for (int rep = 0; rep < 6; ++rep) {
                const int id = tid + 512 * rep, cc = id % 384, ch = id / 384;
                const int col = (cc < 256) ? PA_V + cc : PC_V + (cc - 256);
                const bf16_t* p = proj + (size_t)(r0 + 8 * ch) * INW + col;
                unsigned e[8];
#pragma unroll
                for (int j = 0; j < 8; ++j) e[j] = p[(size_t)j * INW];
                u32x4 o; o.x = e[0] | (e[1] << 16); o.y = e[2] | (e[3] << 16); o.z = e[4] | (e[5] << 16); o.w = e[6] | (e[7] << 16);
                bf16_t* dst = (cc < 256) ? (bf16_t*)(P.ws + WS_VTA) + ((size_t)b * 256 + cc) * TT : (bf16_t*)(P.ws + WS_VTC) + ((size_t)b * 128 + (cc - 256)) * TT;
                *(u32x4*)(dst + t0 + 8 * ch) = o;
            }
        } else {
            float* U = (float*)lds;
            float* U2 = U + 64 * 256;
#pragma unroll
            for (int rep = 0; rep < 4; ++rep) {
                const int id = tid + 512 * rep, tok = id >> 5, ch = id & 31;
                const u32x4 w = *(const u32x4*)(proj + (size_t)(r0 + tok) * INW + PD_U + 8 * ch);
                f32x4 a0 = (f32x4){bflo(w.x), bfhi(w.x), bflo(w.y), bfhi(w.y)}, a1 = (f32x4){bflo(w.z), bfhi(w.z), bflo(w.w), bfhi(w.w)};
                float* d = U + tok * 256 + 8 * ch;
                if (!is_ctx) {
                    const int tg = t0 - CTX + tok, mt = (tg == 0) ? SEQ / 2 : SEQ - tg;
                    const u32x4 m = *(const u32x4*)(proj + ((size_t)b * TT + CTX + mt) * INW + PD_U + 8 * ch);
                    const f32x4 m0 = (f32x4){bflo(m.x), bfhi(m.x), bflo(m.y), bfhi(m.y)}, m1 = (f32x4){bflo(m.z), bfhi(m.z), bflo(m.w), bfhi(m.w)};
                    float* d2 = U2 + tok * 256 + 8 * ch;
                    if (tg == 0) { *(f32x4*)d2 = m0; *(f32x4*)(d2 + 4) = m1; }
                    else { *(f32x4*)d2 = a0 - m0; *(f32x4*)(d2 + 4) = a1 - m1; a0 = a0 + m0; a1 = a1 + m1; }
                }
                *(f32x4*)d = a0; *(f32x4*)(d + 4) = a1;
            }
            __syncthreads();
            const int n0 = (tid & 63) * 4, t8 = (tid >> 6) * 8, cp0 = n0 & 63, g = n0 >> 6;
            const bool sp0 = (!is_ctx) && (t0 == CTX) && (t8 == 0);
            float aC[4][8], aS[4][8];
#pragma unroll
            for (int q = 0; q < 4; ++q)
#pragma unroll
                for (int t = 0; t < 8; ++t) { aC[q][t] = 0.f; aS[q][t] = 0.f; }
            const float* ub = U + t8 * 256 + g * 64;
            const float* ub2 = is_ctx ? ub : ub + 64 * 256;
#pragma unroll 2
            for (int c = 0; c < 64; ++c) {
                float cv[4], sv[4];
#pragma unroll
                for (int q = 0; q < 4; ++q) { const float rev = (float)((c * (cp0 + q)) & 63) * (1.0f / 64.0f); cv[q] = __builtin_amdgcn_cosf(rev) * 0.125f; sv[q] = __builtin_amdgcn_sinf(rev) * 0.125f; }
#pragma unroll
                for (int t = 0; t < 8; ++t) { const float u = ub[t * 256 + c], u2 = ub2[t * 256 + c];
#pragma unroll
                    for (int q = 0; q < 4; ++q) { aC[q][t] += u * cv[q]; aS[q][t] += u2 * ((t == 0 && sp0) ? cv[q] : sv[q]); } }
            }
#pragma unroll
            for (int q = 0; q < 4; ++q) {
                const int n = n0 + q;
                bf16_t* dC; bf16_t* dS;
                if (is_ctx) { bf16_t* z = (bf16_t*)(P.ws + WS_ZCT) + ((size_t)b * 256 + n) * 512 + t0 + t8; dC = z; dS = z + 256; }
                else { bf16_t* z = (bf16_t*)(P.ws + WS_ZT) + ((size_t)b * 256 + n) * 2048 + (t0 - CTX) + t8; dC = z; dS = z + 1024; }
                u32x4 o; o.x = pk2(aC[q][0], aC[q][1]); o.y = pk2(aC[q][2], aC[q][3]); o.z = pk2(aC[q][4], aC[q][5]); o.w = pk2(aC[q][6], aC[q][7]);
                *(u32x4*)dC = o;
                u32x4 s4; s4.x = pk2(aS[q][0], aS[q][1]); s4.y = pk2(aS[q][2], aS[q][3]); s4.z = pk2(aS[q][4], aS[q][5]); s4.w = pk2(aS[q][6], aS[q][7]);
                *(u32x4*)dS = s4;
            }
            __syncthreads();
        }
    }
}

constexpr int AKT = 128;
constexpr int AK_PITCH = 144, AV_PITCH = 2 * AKT + 8  , AK_BYTES = AKT * AK_PITCH  , AV_BYTES = 64 * AV_PITCH  , A_BUF = AK_BYTES + AV_BYTES  ;
constexpr int A_NBUF = 3, A_XOFF = 0;
static_assert(A_NBUF * A_BUF <= LDS_RING && 4 * 32 * 64 * 4 <= A_BUF, "attention LDS");
__device__ __forceinline__ float max3f(float a, float b, float c) { return __builtin_fmaxf(__builtin_fmaxf(a, b), c); }
template <int DK> __device__ __forceinline__ void attn_qk(f32x16 (&p)[2], const LAS unsigned char* kb, const bf16x8 (&qf)[DK / 16]) {
#pragma unroll
    for (int j = 0; j < 2; ++j)
#pragma unroll
        for (int r = 0; r < 16; ++r) p[j][r] = 0.f;
#pragma unroll
    for (int i = 0; i < DK / 16; ++i)
#pragma unroll
        for (int j = 0; j < 2; ++j) {
            const bf16x8 kf = *(const LAS bf16x8*)(kb + j * 32 * AK_PITCH + i * 32);
            p[j] = __builtin_amdgcn_mfma_f32_32x32x16_bf16(kf, qf[i], p[j], 0, 0, 0);
        }
}
__device__ __forceinline__ void attn_softmax_pv(f32x16 (&p)[2], const LAS unsigned char* vb, float& m, float& lsum, f32x16& o0, f32x16& o1, int lane) {
    float ma = max3f(p[0][0], p[1][0], p[0][1]), mb = max3f(p[1][1], p[0][2], p[1][2]);
#pragma unroll
    for (int r = 3; r < 15; r += 2) { ma = max3f(ma, p[0][r], p[1][r]); mb = max3f(mb, p[0][r + 1], p[1][r + 1]); }
    ma = max3f(ma, p[0][15], p[1][15]);
    float mx = fmaxf(ma, mb);
    mx = fmaxf(mx, shx(mx, 32, lane));
    const float mn = fmaxf(m, mx);
    if (__builtin_amdgcn_ballot_w64(mn > m) != 0) {
        const float alpha = fast_exp2(m - mn); lsum *= alpha;
#pragma unroll
        for (int r = 0; r < 16; ++r) { o0[r] *= alpha; o1[r] *= alpha; }
        m = mn;
    }
    const f32x2_t m2 = {m, m};
    f32x2_t ls2 = {0.f, 0.f};
#pragma unroll
    for (int j = 0; j < 2; ++j)
#pragma unroll
        for (int r = 0; r < 16; r += 2) {
            f32x2_t d = (f32x2_t){p[j][r], p[j][r + 1]} - m2;
            d.x = fast_exp2(d.x); d.y = fast_exp2(d.y);
            ls2 += d; p[j][r] = d.x; p[j][r + 1] = d.y;
        }
    lsum += ls2.x + ls2.y;
#pragma unroll
    for (int ks = 0; ks < 4; ++ks) {
        const f32x16& pp = p[ks >> 1]; const int o8 = 8 * (ks & 1);
        u32x4 w; w.x = pk2(pp[o8], pp[o8 + 1]); w.y = pk2(pp[o8 + 2], pp[o8 + 3]); w.z = pk2(pp[o8 + 4], pp[o8 + 5]); w.w = pk2(pp[o8 + 6], pp[o8 + 7]);
        const bf16x8 pf = __builtin_bit_cast(bf16x8, w);
        const u32x2 a0 = *(const LAS u32x2*)(vb + ks * 32), a1 = *(const LAS u32x2*)(vb + ks * 32 + 16);
        const u32x2 c0 = *(const LAS u32x2*)(vb + 32 * AV_PITCH + ks * 32), c1 = *(const LAS u32x2*)(vb + 32 * AV_PITCH + ks * 32 + 16);
        const bf16x8 v0 = __builtin_bit_cast(bf16x8, ((u32x4){a0.x, a0.y, a1.x, a1.y})), v1 = __builtin_bit_cast(bf16x8, ((u32x4){c0.x, c0.y, c1.x, c1.y}));
        o0 = __builtin_amdgcn_mfma_f32_32x32x16_bf16(v0, pf, o0, 0, 0, 0);
        o1 = __builtin_amdgcn_mfma_f32_32x32x16_bf16(v1, pf, o1, 0, 0, 0);
    }
}
template <int DK, bool IS_A>
__device__ __forceinline__ void attn_unit(const Params& P, int l, LAS unsigned char* lds, int b, int grp, int qtok0, int nkeys) {
    const int tid = opaque_tid(), lane = tid & 63, wave = tid >> 6, s = wave >> 2, wq = wave & 3, r32 = lane & 31, hi = lane >> 5;
    const bf16_t* proj = (const bf16_t*)(P.ws + WS_PROJ);
    bf16_t* mix = (bf16_t*)(P.ws + WS_H);
    const int qcol = IS_A ? PA_Q + grp * 64 + s * 32 : PC_Q + (2 * grp + s) * 64;
    const int kcol = IS_A ? PA_K + grp * 64 : PC_K + grp * 64;
    const int koff = IS_A ? s * 32 : 0;
    const bf16_t* VT = IS_A ? (const bf16_t*)(P.ws + WS_VTA) + ((size_t)(b * 4 + grp) * 64) * TT : (const bf16_t*)(P.ws + WS_VTC) + ((size_t)(b * 2 + grp) * 64) * TT;
    const size_t qrow = (size_t)b * TT + qtok0 + wq * 64 + r32;
    bf16x8 qa[DK / 16], qb[DK / 16];
#pragma unroll
    for (int i = 0; i < DK / 16; ++i) { qa[i] = *(const bf16x8*)(proj + qrow * INW + qcol + i * 16 + hi * 8); qb[i] = *(const bf16x8*)(proj + (qrow + 32) * INW + qcol + i * 16 + hi * 8); }
    const int lrow = tid >> 3, lch = tid & 7;
    const bf16_t* ksrc = proj + ((size_t)b * TT + lrow) * INW + kcol + lch * 8;
    const bf16_t* vsrc = VT + (size_t)lrow * TT + lch * 8;
    const int NT = nkeys / AKT;
    u32x4 kreg0, kreg1, vreg0, vreg1;
#define AT_LOAD(t_) do { const bf16_t* kn = ksrc + (size_t)(t_) * AKT * INW; const bf16_t* vn = vsrc + (t_) * AKT; \
        kreg0 = *(const u32x4*)kn; kreg1 = *(const u32x4*)(kn + (size_t)64 * INW); vreg0 = *(const u32x4*)vn; vreg1 = *(const u32x4*)(vn + 64); } while (0)
#define AT_STORE(nb) do { LAS unsigned char* kd_ = lds + (nb) * A_BUF + lrow * AK_PITCH + lch * 16; LAS unsigned char* vd_ = lds + (nb) * A_BUF + AK_BYTES + lrow * AV_PITCH + lch * 16; \
        *(LAS u32x4*)kd_ = kreg0; *(LAS u32x4*)(kd_ + 64 * AK_PITCH) = kreg1; \
        *(LAS u32x2*)vd_ = (u32x2){vreg0.x, vreg0.y}; *(LAS u32x2*)(vd_ + 8) = (u32x2){vreg0.z, vreg0.w}; \
        *(LAS u32x2*)(vd_ + 128) = (u32x2){vreg1.x, vreg1.y}; *(LAS u32x2*)(vd_ + 136) = (u32x2){vreg1.z, vreg1.w}; } while (0)
    const int kfo = r32 * AK_PITCH + (koff + 8 * hi) * 2, vfo = AK_BYTES + r32 * AV_PITCH + 8 * hi;
    AT_LOAD(0); AT_STORE(0);
    __syncthreads();
    float ma = -1e30f, mb = -1e30f, la = 0.f, lb_ = 0.f;
    f32x16 oa0, oa1, ob0, ob1;
#pragma unroll
    for (int r = 0; r < 16; ++r) { oa0[r] = 0.f; oa1[r] = 0.f; ob0[r] = 0.f; ob1[r] = 0.f; }
    for (int t = 0; t < NT; ++t) {
        const int buf = t & 1;
        if (t + 1 < NT) AT_LOAD(t + 1);
#pragma unroll
        for (int h = 0; h < 2; ++h) {
            const LAS unsigned char* kb = lds + buf * A_BUF + kfo + h * 64 * AK_PITCH;
            const LAS unsigned char* vb = lds + buf * A_BUF + vfo + h * 128;
            f32x16 pa[2], pb[2];
#pragma unroll
            for (int jj = 0; jj < 2; ++jj)
#pragma unroll
                for (int r = 0; r < 16; ++r) { pa[jj][r] = 0.f; pb[jj][r] = 0.f; }
#pragma unroll
            for (int i = 0; i < DK / 16; ++i)
#pragma unroll
                for (int jj = 0; jj < 2; ++jj) {
                    const bf16x8 kf = *(const LAS bf16x8*)(kb + jj * 32 * AK_PITCH + i * 32);
                    pa[jj] = __builtin_amdgcn_mfma_f32_32x32x16_bf16(kf, qa[i], pa[jj], 0, 0, 0);
                    pb[jj] = __builtin_amdgcn_mfma_f32_32x32x16_bf16(kf, qb[i], pb[jj], 0, 0, 0);
                }
#define AT_SOFTMAX(PP, M, L, O0, O1) do { \
                float x0 = max3f(PP[0][0], PP[1][0], PP[0][1]), x1 = max3f(PP[1][1], PP[0][2], PP[1][2]); \
                _Pragma("unroll") for (int r = 3; r < 15; r += 2) { x0 = max3f(x0, PP[0][r], PP[1][r]); x1 = max3f(x1, PP[0][r + 1], PP[1][r + 1]); } \
                x0 = max3f(x0, PP[0][15], PP[1][15]); \
                float mx = fmaxf(x0, x1); mx = fmaxf(mx, shx(mx, 32, lane)); \
                const float mn = fmaxf(M, mx); \
                if (__builtin_amdgcn_ballot_w64(mn > M) != 0) { const float alpha = fast_exp2(M - mn); L *= alpha; \
                    _Pragma("unroll") for (int r = 0; r < 16; ++r) { O0[r] *= alpha; O1[r] *= alpha; } M = mn; } \
                float ls = 0.f; \
                _Pragma("unroll") for (int jj = 0; jj < 2; ++jj) _Pragma("unroll") for (int r = 0; r < 16; ++r) { PP[jj][r] = fast_exp2(PP[jj][r] - M); ls += PP[jj][r]; } \
                L += ls; } while (0)
            AT_SOFTMAX(pa, ma, la, oa0, oa1);
            AT_SOFTMAX(pb, mb, lb_, ob0, ob1);
#undef AT_SOFTMAX
#pragma unroll
            for (int ks = 0; ks < 4; ++ks) {
                const int o8 = 8 * (ks & 1);
                u32x4 w; const f32x16& xa = pa[ks >> 1]; const f32x16& xb = pb[ks >> 1];
                w.x = pk2(xa[o8], xa[o8 + 1]); w.y = pk2(xa[o8 + 2], xa[o8 + 3]); w.z = pk2(xa[o8 + 4], xa[o8 + 5]); w.w = pk2(xa[o8 + 6], xa[o8 + 7]);
                const bf16x8 pfa = __builtin_bit_cast(bf16x8, w);
                w.x = pk2(xb[o8], xb[o8 + 1]); w.y = pk2(xb[o8 + 2], xb[o8 + 3]); w.z = pk2(xb[o8 + 4], xb[o8 + 5]); w.w = pk2(xb[o8 + 6], xb[o8 + 7]);
                const bf16x8 pfb = __builtin_bit_cast(bf16x8, w);
                const u32x2 a0 = *(const LAS u32x2*)(vb + ks * 32), a1 = *(const LAS u32x2*)(vb + ks * 32 + 16);
                const u32x2 c0 = *(const LAS u32x2*)(vb + 32 * AV_PITCH + ks * 32), c1 = *(const LAS u32x2*)(vb + 32 * AV_PITCH + ks * 32 + 16);
                const bf16x8 v0 = __builtin_bit_cast(bf16x8, ((u32x4){a0.x, a0.y, a1.x, a1.y})), v1 = __builtin_bit_cast(bf16x8, ((u32x4){c0.x, c0.y, c1.x, c1.y}));
                oa0 = __builtin_amdgcn_mfma_f32_32x32x16_bf16(v0, pfa, oa0, 0, 0, 0);
                oa1 = __builtin_amdgcn_mfma_f32_32x32x16_bf16(v1, pfa, oa1, 0, 0, 0);
                ob0 = __builtin_amdgcn_mfma_f32_32x32x16_bf16(v0, pfb, ob0, 0, 0, 0);
                ob1 = __builtin_amdgcn_mfma_f32_32x32x16_bf16(v1, pfb, ob1, 0, 0, 0);
            }
        }
        if (t + 1 < NT) AT_STORE(buf ^ 1);
        __syncthreads();
    }
#undef AT_LOAD
#undef AT_STORE
    la += shx(la, 32, lane); lb_ += shx(lb_, 32, lane);
    { const float ia = 1.0f / la, ib = 1.0f / lb_;
#pragma unroll
      for (int r = 0; r < 16; ++r) { oa0[r] *= ia; oa1[r] *= ia; ob0[r] *= ib; ob1[r] *= ib; } }
#define AT_OUT(O0, O1, ROW, COL0, SCALE_G) do { bf16_t* orow = mix + (ROW) * DM + (COL0); \
        _Pragma("unroll") for (int db = 0; db < 2; ++db) _Pragma("unroll") for (int r4 = 0; r4 < 4; ++r4) { \
            const int d0 = 32 * db + 8 * r4 + 4 * hi; const f32x16& o = db ? O1 : O0; f32x4 g4 = (f32x4){1.f, 1.f, 1.f, 1.f}; \
            if (SCALE_G) g4 = *(const f32x4*)(gn + d0) * rs_; \
            u32x2 w; w.x = pk2(o[4 * r4] * g4.x, o[4 * r4 + 1] * g4.y); w.y = pk2(o[4 * r4 + 2] * g4.z, o[4 * r4 + 3] * g4.w); \
            *(u32x2*)(orow + d0) = w; } } while (0)
    if (IS_A) {
        LAS float* X = (LAS float*)lds;
        if (s == 1) {
#pragma unroll
            for (int r = 0; r < 16; ++r) { X[(wq * 64 + r) * 64 + lane] = oa0[r]; X[(wq * 64 + 16 + r) * 64 + lane] = oa1[r]; X[(wq * 64 + 32 + r) * 64 + lane] = ob0[r]; X[(wq * 64 + 48 + r) * 64 + lane] = ob1[r]; }
        }
        __syncthreads();
        if (s == 0) {
            const float lam = ((const float*)(P.ws + WS_CTL))[CW_LAM + l];
            const float oml_init = ((const float*)(P.ws + WS_CTL))[CW_LAM + 8 + l];
            const float* gn = P.diff_norm + (size_t)l * 64;
            float sa = 0.f, sb = 0.f;
#pragma unroll
            for (int r = 0; r < 16; ++r) {
                oa0[r] -= lam * X[(wq * 64 + r) * 64 + lane]; oa1[r] -= lam * X[(wq * 64 + 16 + r) * 64 + lane]; sa += oa0[r] * oa0[r] + oa1[r] * oa1[r];
                ob0[r] -= lam * X[(wq * 64 + 32 + r) * 64 + lane]; ob1[r] -= lam * X[(wq * 64 + 48 + r) * 64 + lane]; sb += ob0[r] * ob0[r] + ob1[r] * ob1[r]; }
            sa += shx(sa, 32, lane); sb += shx(sb, 32, lane);
            { const float rs_ = (1.0f / sqrtf(sa * (1.0f / 64.0f) + RMS_EPS)) * oml_init; AT_OUT(oa0, oa1, qrow, grp * 64, true); }
            { const float rs_ = (1.0f / sqrtf(sb * (1.0f / 64.0f) + RMS_EPS)) * oml_init; AT_OUT(ob0, ob1, qrow + 32, grp * 64, true); }
        }
        __syncthreads();
    } else {
        const float* gn = nullptr; const float rs_ = 1.f;
        AT_OUT(oa0, oa1, qrow, 512 + (2 * grp + s) * 64, false);
        AT_OUT(ob0, ob1, qrow + 32, 512 + (2 * grp + s) * 64, false);
    }
#undef AT_OUT
}

__device__ __forceinline__ void hgrn_unit(const Params& P, int l, LAS unsigned char* lds, int b, int h, int dir) {
    const int tid = opaque_tid(), lane = tid & 63, wave = tid >> 6;
    const bf16_t* proj = (const bf16_t*)(P.ws + WS_PROJ);
    float* odir = (float*)(P.ws + WS_ODIR) + (size_t)dir * ROWS * 256;
    constexpr int HC = 32, NCH = TT / HC;
    LAS float* Kk = (LAS float*)lds; LAS float* Q = Kk + HC * 64; LAS float* V = Q + HC * 64; LAS float* Pp = V + HC * 64;
    const int d0 = 4 * (tid & 15), sst = tid >> 4;
    const f32x4 lb4 = *(const f32x4*)((const float*)(P.ws + WS_CTL) + CW_LB + ((size_t)dir * DEPTH + l) * 256 + h * 64 + d0);
    const f32x4 oml = 1.0f - lb4;
    const int zc = (dir ? PB_FB : PB_FF) + h * 64 + d0, qc = PB_Q + h * 64 + d0, vc = PB_I + h * 64 + d0;
    u32x2 rq, rz, rv;
#define HG_CHUNK(ci) (dir ? (((ci) < 8) ? 7 - (ci) : 79 - (ci)) : (ci))
#define HG_TOK(ci) ((size_t)b * TT + HG_CHUNK(ci) * HC + (dir ? HC - 1 - sst : sst))
#define HG_LOAD(ci) do { const bf16_t* pr_ = proj + HG_TOK(ci) * INW; rq = *(const u32x2*)(pr_ + qc); rz = *(const u32x2*)(pr_ + zc); rv = *(const u32x2*)(pr_ + vc); } while (0)
    HG_LOAD(0);
    float S[8];
#pragma unroll
    for (int i = 0; i < 8; ++i) S[i] = 0.f;
    for (int ci = 0; ci < NCH; ++ci) {
        {
            f32x4 sg; sg.x = sigmoidf_(-bflo(rz.x)); sg.y = sigmoidf_(-bfhi(rz.x)); sg.z = sigmoidf_(-bflo(rz.y)); sg.w = sigmoidf_(-bfhi(rz.y));
            *(LAS f32x4*)(Kk + sst * 64 + d0) = oml * sg;
            *(LAS f32x4*)(Q + sst * 64 + d0) = (f32x4){bflo(rq.x), bfhi(rq.x), bflo(rq.y), bfhi(rq.y)};
            *(LAS f32x4*)(V + sst * 64 + d0) = (f32x4){bflo(rv.x), bfhi(rv.x), bflo(rv.y), bfhi(rv.y)};
        }
        __syncthreads();
        if (ci + 1 < NCH) HG_LOAD(ci + 1);
        const LAS float* kp = Kk + 8 * wave; const LAS float* qp = Q + 8 * wave; const LAS float* vp = V + lane; LAS float* pp = Pp + wave * (HC * 64) + lane;
        f32x4 ka = *(const LAS f32x4*)kp, kb = *(const LAS f32x4*)(kp + 4), qa = *(const LAS f32x4*)qp, qb = *(const LAS f32x4*)(qp + 4);
        float v = vp[0];
#pragma unroll 4
        for (int st = 0; st < HC; ++st) {
            const int sn = (st + 1) & (HC - 1);
            const f32x4 nka = *(const LAS f32x4*)(kp + sn * 64), nkb = *(const LAS f32x4*)(kp + sn * 64 + 4), nqa = *(const LAS f32x4*)(qp + sn * 64), nqb = *(const LAS f32x4*)(qp + sn * 64 + 4);
            const float nv = vp[sn * 64];
            S[0] += ka.x * (v - S[0]); S[1] += ka.y * (v - S[1]); S[2] += ka.z * (v - S[2]); S[3] += ka.w * (v - S[3]);
            S[4] += kb.x * (v - S[4]); S[5] += kb.y * (v - S[5]); S[6] += kb.z * (v - S[6]); S[7] += kb.w * (v - S[7]);
            pp[st * 64] = ((S[0] * qa.x + S[1] * qa.y) + (S[2] * qa.z + S[3] * qa.w)) + ((S[4] * qb.x + S[5] * qb.y) + (S[6] * qb.z + S[7] * qb.w));
            ka = nka; kb = nkb; qa = nqa; qb = nqb; v = nv;
        }
        __syncthreads();
        {
            f32x4 o = *(const LAS f32x4*)(Pp + sst * 64 + d0);
#pragma unroll
            for (int w = 1; w < 8; ++w) o = o + *(const LAS f32x4*)(Pp + w * (HC * 64) + sst * 64 + d0);
            *(f32x4*)(odir + HG_TOK(ci) * 256 + h * 64 + d0) = o;
        }
    }
    __syncthreads();
#undef HG_CHUNK
#undef HG_TOK
#undef HG_LOAD
}

constexpr int HM_QP = 144, HM_QT = 0, HM_KT = 2304, HM_KD = 4608, HM_VT = 6656, HM_EB = 8704, HM_WAVE = 8960;
__device__ __forceinline__ void hm_stage(LAS unsigned char* wl, const unsigned (&rq)[16], const unsigned (&rz)[16], const unsigned (&rv)[16], float oml, int lane) {
    float kt[16]; float run = 1.0f;
    unsigned vpk[8];
#pragma unroll
    for (int i = 0; i < 16; ++i) {
        const float z = bf2f(rz[i]), q = bf2f(rq[i]);
        const float sg = __builtin_amdgcn_rcpf(1.0f + fast_exp2(z * LOG2E));
        const float k = oml * sg;
        run = fmaxf(run * (1.0f - k), 8.673617379884035e-19f);
        const float ieb = __builtin_amdgcn_rcpf(run);
        kt[i] = k * ieb;
        *(LAS unsigned short*)(wl + HM_QT + i * HM_QP + lane * 2) = (unsigned short)pk2(q * run, 0.f);
        *(LAS unsigned short*)(wl + HM_KT + i * HM_QP + lane * 2) = (unsigned short)pk2(kt[i], 0.f);
        if (i & 1) vpk[i >> 1] = rv[i - 1] | (rv[i] << 16);
    }
    const float eB = run;
    *(LAS float*)(wl + HM_EB + lane * 4) = eB;
    u32x4 w0, w1;
    w0.x = pk2(kt[0] * eB, kt[1] * eB); w0.y = pk2(kt[2] * eB, kt[3] * eB); w0.z = pk2(kt[4] * eB, kt[5] * eB); w0.w = pk2(kt[6] * eB, kt[7] * eB);
    w1.x = pk2(kt[8] * eB, kt[9] * eB); w1.y = pk2(kt[10] * eB, kt[11] * eB); w1.z = pk2(kt[12] * eB, kt[13] * eB); w1.w = pk2(kt[14] * eB, kt[15] * eB);
    *(LAS u32x4*)(wl + HM_KD + lane * 32) = w0; *(LAS u32x4*)(wl + HM_KD + lane * 32 + 16) = w1;
    *(LAS u32x4*)(wl + HM_VT + lane * 32) = (u32x4){vpk[0], vpk[1], vpk[2], vpk[3]}; *(LAS u32x4*)(wl + HM_VT + lane * 32 + 16) = (u32x4){vpk[4], vpk[5], vpk[6], vpk[7]};
}
__device__ __forceinline__ void hm_mfma(const LAS unsigned char* wl, f32x4 (&S)[4][4], f32x4 (&o)[4], int c16, int g) {
    const bf16x8 zero8 = {0, 0, 0, 0, 0, 0, 0, 0};
    f32x4 sc = (f32x4){0.f, 0.f, 0.f, 0.f};
#pragma unroll
    for (int kk = 0; kk < 2; ++kk) {
        const bf16x8 a = *(const LAS bf16x8*)(wl + HM_KT + c16 * HM_QP + (32 * kk + 8 * g) * 2);
        const bf16x8 bq = *(const LAS bf16x8*)(wl + HM_QT + c16 * HM_QP + (32 * kk + 8 * g) * 2);
        sc = __builtin_amdgcn_mfma_f32_16x16x32_bf16(a, bq, sc, 0, 0, 0);
    }
#pragma unroll
    for (int r = 0; r < 4; ++r) if (4 * g + r > c16) sc[r] = 0.f;
    bf16x8 pb; { u32x4 w; w.x = pk2(sc[0], sc[1]); w.y = pk2(sc[2], sc[3]); w.z = 0u; w.w = 0u; pb = __builtin_bit_cast(bf16x8, w); }
    bf16x8 qb[2];
#pragma unroll
    for (int kk = 0; kk < 2; ++kk) {
        const u32x2 lo = *(const LAS u32x2*)(wl + HM_QT + c16 * HM_QP + (32 * kk + 4 * g) * 2), hi2 = *(const LAS u32x2*)(wl + HM_QT + c16 * HM_QP + (32 * kk + 16 + 4 * g) * 2);
        qb[kk] = __builtin_bit_cast(bf16x8, ((u32x4){lo.x, lo.y, hi2.x, hi2.y}));
    }
#pragma unroll
    for (int eb = 0; eb < 4; ++eb) {
        const u32x2 va = *(const LAS u32x2*)(wl + HM_VT + (16 * eb + c16) * 32 + 8 * g);
        const bf16x8 a = __builtin_bit_cast(bf16x8, ((u32x4){va.x, va.y, 0u, 0u}));
        f32x4 acc = __builtin_amdgcn_mfma_f32_16x16x32_bf16(a, pb, (f32x4){0.f, 0.f, 0.f, 0.f}, 0, 0, 0);
#pragma unroll
        for (int kk = 0; kk < 2; ++kk) {
            const f32x4 s0 = S[2 * kk][eb], s1 = S[2 * kk + 1][eb];
            u32x4 w; w.x = pk2(s0[0], s0[1]); w.y = pk2(s0[2], s0[3]); w.z = pk2(s1[0], s1[1]); w.w = pk2(s1[2], s1[3]);
            acc = __builtin_amdgcn_mfma_f32_16x16x32_bf16(__builtin_bit_cast(bf16x8, w), qb[kk], acc, 0, 0, 0);
        }
        o[eb] = acc;
    }
    bf16x8 af[4], bf[4]; f32x4 e4[4];
#pragma unroll
    for (int x = 0; x < 4; ++x) {
        af[x] = (g < 2) ? *(const LAS bf16x8*)(wl + HM_KD + (16 * x + c16) * 32 + 16 * g) : zero8;
        bf[x] = (g < 2) ? *(const LAS bf16x8*)(wl + HM_VT + (16 * x + c16) * 32 + 16 * g) : zero8;
        e4[x] = *(const LAS f32x4*)(wl + HM_EB + (16 * x + 4 * g) * 4);
    }
#pragma unroll
    for (int mb = 0; mb < 4; ++mb)
#pragma unroll
        for (int nb = 0; nb < 4; ++nb) S[mb][nb] = __builtin_amdgcn_mfma_f32_16x16x32_bf16(af[mb], bf[nb], S[mb][nb] * e4[mb], 0, 0, 0);
}
__device__ __forceinline__ void hgrn_mfma_unit(const Params& P, int l, LAS unsigned char* lds, int b, int half) {
    const int tid = opaque_tid(), lane = tid & 63, wave = tid >> 6, c16 = lane & 15, g = lane >> 4;
    if (wave < 4) {
        const int idx = 4 * half + wave, h = idx >> 1, dir = idx & 1;
        const bf16_t* proj = (const bf16_t*)(P.ws + WS_PROJ);
        float* odir = (float*)(P.ws + WS_ODIR) + (size_t)dir * ROWS * 256;
        LAS unsigned char* wl = lds + wave * HM_WAVE;
        const float lb = ((const float*)(P.ws + WS_CTL))[CW_LB + ((size_t)dir * DEPTH + l) * 256 + h * 64 + lane];
        const float oml = 1.0f - lb;
        const int qc = PB_Q + h * 64 + lane, zc = (dir ? PB_FB : PB_FF) + h * 64 + lane, vc = PB_I + h * 64 + lane;
        const size_t tb = (size_t)b * TT;
#define HM_TOK(p_) (tb + (dir ? (((p_) < CTX) ? (CTX - 1 - (p_)) : (TT + CTX - 1 - (p_))) : (p_)))
#define HM_LOAD(RQ, RZ, RV, j_) do { _Pragma("unroll") for (int i = 0; i < 16; ++i) { const bf16_t* pr_ = proj + HM_TOK((j_) * 16 + i) * INW; RQ[i] = pr_[qc]; RZ[i] = pr_[zc]; RV[i] = pr_[vc]; } } while (0)
#define HM_STORE_O(j_) do { float* op = odir + HM_TOK((j_) * 16 + c16) * 256 + h * 64 + 4 * g; _Pragma("unroll") for (int eb = 0; eb < 4; ++eb) *(f32x4*)(op + 16 * eb) = o[eb]; } while (0)
        unsigned aq[16], az[16], av[16], bq[16], bz[16], bv[16];
        HM_LOAD(aq, az, av, 0); HM_LOAD(bq, bz, bv, 1);
        f32x4 S[4][4];
#pragma unroll
        for (int mb = 0; mb < 4; ++mb)
#pragma unroll
            for (int nb = 0; nb < 4; ++nb) S[mb][nb] = (f32x4){0.f, 0.f, 0.f, 0.f};
        f32x4 o[4];
        constexpr int NSC = TT / 16;
        for (int j = 0; j < NSC; j += 2) {
            hm_stage(wl, aq, az, av, oml, lane);
            if (j + 2 < NSC) HM_LOAD(aq, az, av, j + 2);
            hm_mfma(wl, S, o, c16, g);
            HM_STORE_O(j);
            hm_stage(wl, bq, bz, bv, oml, lane);
            if (j + 3 < NSC) HM_LOAD(bq, bz, bv, j + 3);
            hm_mfma(wl, S, o, c16, g);
            HM_STORE_O(j + 1);
        }
#undef HM_TOK
#undef HM_LOAD
#undef HM_STORE_O
    }
    __syncthreads();
}

__device__ __forceinline__ unsigned xb_xcc_id();
__device__ __forceinline__ void phase_mix(const Params& P, int l, unsigned char* lds_g, int rep = 0) {
    LAS unsigned char* lds = (LAS unsigned char*)lds_g;
    unsigned* ctr = (unsigned*)(P.ws + WS_CTL) + CW_QUEUE + 64 * 8 * l;
    volatile LAS int* slot = (volatile LAS int*)(lds + LDS_MISC);
    const bool need_ctx = l < DEPTH - 1;
    constexpr int N_F = 16, N_H = 4, N_C = 32, N_A = 64, N_FC = 2, N_AC = 8, N_CC = 4;
    const int per = N_F + N_H + N_C + N_A + (need_ctx ? N_FC + N_AC + N_CC : 0);
    const int x0 = (int)(xb_xcc_id() & 7u);
    int sfirst = 0;
    for (;;) {
        if (opaque_tid() == 0) {
            int enc = -1;
            while (sfirst < 8) {
                const int xs = (x0 + sfirst) & 7;
                const unsigned j = atomicAdd(ctr + 64 * xs, 1u);
                if ((int)j < per) { enc = xs * 256 + (int)j; break; }
                ++sfirst;
            }
            *slot = enc;
        }
        __syncthreads();
        const int enc = *slot;
        __syncthreads();
        if (enc < 0) break;
        const int x = enc >> 8; int it = enc & 255;
        if (it < N_F) { const int f = x * N_F + it;
            pg8::Gemm g{(const pg8::bf16_t*)(P.ws + WS_FMAT), (const pg8::bf16_t*)(P.ws + WS_ZT), SEQ, NBATCH * 256, 2048}; OneUnit S{f & 7, f >> 3};
            pg8::EpiBf16<0> E{(pg8::bf16_t*)(P.ws + WS_H) + (size_t)CTX * DM + 768, DM, nullptr, 256, (size_t)TT * DM, 1.0f};
            pg8::gemm_phase<pg8::EpiBf16<0>, OneUnit, false, true>(lds, g, S, E); __syncthreads(); continue; } it -= N_F;
        if (it < N_H) { const int hh = x * N_H + it; hgrn_mfma_unit(P, l, lds, hh >> 1, hh & 1); continue; } it -= N_H;
        if (it < N_C) { const int c = x * N_C + it; attn_unit<64, false>(P, l, lds, c >> 4, (c >> 3) & 1, CTX + (c & 7) * 256, TT); continue; } it -= N_C;
        if (it < N_A) { const int a = x * N_A + it; attn_unit<32, true>(P, l, lds, a >> 5, (a >> 3) & 3, CTX + (a & 7) * 256, TT); continue; } it -= N_A;
        if (it < N_FC) { const int f = x * N_FC + it;
            pg8::Gemm g{(const pg8::bf16_t*)(P.ws + WS_FC), (const pg8::bf16_t*)(P.ws + WS_ZCT), CTX, NBATCH * 256, 512}; OneUnit S{0, f};
            pg8::EpiBf16<0> E{(pg8::bf16_t*)(P.ws + WS_H) + 768, DM, nullptr, 256, (size_t)TT * DM, 1.0f};
            pg8::gemm_phase<pg8::EpiBf16<0>, OneUnit, false, true>(lds, g, S, E); __syncthreads(); continue; } it -= N_FC;
        if (it < N_AC) { const int a = x * N_AC + it; attn_unit<32, true>(P, l, lds, a >> 2, a & 3, 0, CTX); continue; } it -= N_AC;
        { const int c = x * N_CC + it; attn_unit<64, false>(P, l, lds, c >> 1, c & 1, 0, CTX); }
    }
}

__device__ __forceinline__ void phase_hfin(const Params& P, int l) {
    const float* od0 = (const float*)(P.ws + WS_ODIR); const float* od1 = od0 + (size_t)ROWS * 256;
    const bf16_t* proj = (const bf16_t*)(P.ws + WS_PROJ); bf16_t* mix = (bf16_t*)(P.ws + WS_H);
    const float* gn = P.hgrn_norm + (size_t)l * 64;
    const long total = (long)ROWS * 4 * 16;
    const int tid = opaque_tid(), lane = tid & 63;
    for (long i = (long)blockIdx.x * 512 + tid; i < total; i += (long)gridDim.x * 512) {
        const int sub = (int)(i & 15); const long rh = i >> 4; const int h = (int)(rh & 3); const long r = rh >> 2;
        const size_t off = (size_t)r * 256 + h * 64 + sub * 4;
        const f32x4 a = *(const f32x4*)(od0 + off), b2 = *(const f32x4*)(od1 + off);
        const f32x4 o = a + b2;
        float ss = (o.x * o.x + o.y * o.y) + (o.z * o.z + o.w * o.w);
        ss += shx(ss, 1, lane); ss += shx(ss, 2, lane); ss += shx(ss, 4, lane); ss += shx(ss, 8, lane);
        const float rs = 1.0f / sqrtf(ss * (1.0f / 64.0f) + RMS_EPS);
        const u32x2 gw = *(const u32x2*)(proj + (size_t)r * INW + PB_G + h * 64 + sub * 4);
        const float g0 = bflo(gw.x), g1 = bfhi(gw.x), g2 = bflo(gw.y), g3 = bfhi(gw.y);
        const f32x4 gg = *(const f32x4*)(gn + sub * 4);
        u32x2 w; w.x = pk2(o.x * rs * gg.x * (g0 * sigmoidf_(g0)), o.y * rs * gg.y * (g1 * sigmoidf_(g1))); w.y = pk2(o.z * rs * gg.z * (g2 * sigmoidf_(g2)), o.w * rs * gg.w * (g3 * sigmoidf_(g3)));
        *(u32x2*)(mix + (size_t)r * DM + 256 + h * 64 + sub * 4) = w;
    }
}

#define XB_TMO      128
#define XB_XCNT(j)  (256  + 64 * (j))
#define XB_XSUB(j)  (1280 + 64 * (j))
#define XB_XGEN(j)  (2304 + 64 * (j))
#define XB_TOP      3328
#define XB_TOPGEN   3392
#define XCD_BAR_WORDS 3456
#define XB_SPIN_CAP (1u << 18)

__device__ __forceinline__ unsigned xb_ld(unsigned* p)              { return __hip_atomic_load(p, __ATOMIC_RELAXED, __HIP_MEMORY_SCOPE_AGENT); }
__device__ __forceinline__ unsigned xb_add(unsigned* p, unsigned v) { return __hip_atomic_fetch_add(p, v, __ATOMIC_RELAXED, __HIP_MEMORY_SCOPE_AGENT); }
__device__ __forceinline__ unsigned xb_xcc_id() { return (unsigned)__builtin_amdgcn_s_getreg((3 << 11) | 20) & 0xFu; }
#define XB_SPIN(cond, bar) do { unsigned _sp = 0; while (cond) { __builtin_amdgcn_s_sleep(1); \
    if ((++_sp & 255u) == 0u) { if (xb_ld(&(bar)[XB_TMO])) break; if (_sp > XB_SPIN_CAP) { atomicAdd(&(bar)[XB_TMO], 1u); break; } } } } while (0)

struct XcdBarrier {
    unsigned* bar; unsigned x;
    volatile LAS unsigned* st;
};

__device__ __forceinline__ XcdBarrier xcd_barrier_post(unsigned* bar, volatile LAS unsigned* st) {
    XcdBarrier b; b.bar = bar; b.x = xb_xcc_id(); b.st = st;
    if (threadIdx.x == 0) (void)xb_add(&bar[XB_XCNT(b.x)], 1u);
    return b;
}
__device__ __forceinline__ void xcd_barrier_complete(unsigned* bar, unsigned x, unsigned& nloc, unsigned& nx) {
    const unsigned G = gridDim.x * gridDim.y * gridDim.z;
    unsigned sum, cnt, mine, sp = 0u;
    for (;;) {
        sum = 0u; cnt = 0u; mine = 0u;
#pragma unroll
        for (unsigned j = 0; j < 16; ++j) { const unsigned c = xb_ld(&bar[XB_XCNT(j)]); sum += c; cnt += (c > 0u) ? 1u : 0u; mine = (j == x) ? c : mine; }
        if (sum == G) break;
        __builtin_amdgcn_s_sleep(1);
        if ((++sp & 255u) == 0u) { if (xb_ld(&bar[XB_TMO])) break; if (sp > XB_SPIN_CAP) { atomicAdd(&bar[XB_TMO], 1u); break; } }
    }
    nloc = mine > 0u ? mine : 1u; nx = cnt > 0u ? cnt : 1u;
}

__device__ __forceinline__ void xcd_barrier(const XcdBarrier& b) {
    asm volatile("s_waitcnt vmcnt(0)" ::: "memory");
    __syncthreads();
    if (threadIdx.x == 0) {
        unsigned* bar = b.bar;
        __builtin_amdgcn_s_waitcnt(0);
        unsigned nloc = b.st[0], nx = b.st[1];
        if (nloc == 0u) { xcd_barrier_complete(bar, b.x, nloc, nx); b.st[0] = nloc; b.st[1] = nx; }
        const unsigned old = xb_add(&bar[XB_XSUB(b.x)], 1u);
        const unsigned gen = old / nloc;
        if (old + 1u == (gen + 1u) * nloc) {
            __builtin_amdgcn_fence(__ATOMIC_RELEASE, "agent");
            asm volatile("s_waitcnt vmcnt(0)" ::: "memory");
            const unsigned og = xb_add(&bar[XB_TOP], 1u);
            const unsigned tg = og / nx;
            if (og + 1u == (tg + 1u) * nx) xb_add(&bar[XB_TOPGEN], 1u);
            else XB_SPIN(xb_ld(&bar[XB_TOPGEN]) == tg, bar);
            __builtin_amdgcn_fence(__ATOMIC_ACQUIRE, "agent");
            xb_add(&bar[XB_XGEN(b.x)], 1u);
            asm volatile("s_waitcnt vmcnt(0)" ::: "memory");
        } else {
            XB_SPIN(xb_ld(&bar[XB_XGEN(b.x)]) == gen, bar);
            __builtin_amdgcn_fence(__ATOMIC_ACQUIRE, "agent");
            asm volatile("s_waitcnt vmcnt(0)" ::: "memory");
        }
    }
    __syncthreads();
}

static_assert(XCD_BAR_WORDS_C == XCD_BAR_WORDS, "barrier words");
#ifndef RES_ALIGN
#define RES_ALIGN true
#endif
#ifndef REP_MIX
#define REP_MIX 1
#endif
#ifndef REP_G1
#define REP_G1 1
#endif
#ifndef REP_G3
#define REP_G3 1
#endif
#ifndef REP_PREPD
#define REP_PREPD 1
#endif
typedef const __attribute__((address_space(4))) Params* KParams;
__device__ __forceinline__ Params fresh_params() {
#if defined(__HIP_DEVICE_COMPILE__)
    KParams q = (KParams)__builtin_amdgcn_kernarg_segment_ptr(); asm volatile("" : "+s"(q)); return *q;
#else
    return Params{};
#endif
}
__global__ void __launch_bounds__(512, 2) hybrid_fwd(Params Parg) {
    extern __shared__ __attribute__((aligned(16))) unsigned char lds[];
    cg::grid_group grid = cg::this_grid();
    LAS unsigned char* ldsl = (LAS unsigned char*)lds;
    volatile LAS unsigned* bst = (volatile LAS unsigned*)(ldsl + LDS_MISC + 64);
    if (threadIdx.x == 0) { bst[0] = 0u; bst[1] = 0u; }
    { const Params P = fresh_params(); phase_init(P, lds); }
    grid.sync();
    XcdBarrier bar;
    { const Params P = fresh_params(); bar = xcd_barrier_post((unsigned*)(P.ws + WS_CTL) + CW_BAR, bst); }
#pragma unroll 1
    for (int l = 0; l < DEPTH; ++l) {
        const bool lat_only = (l == DEPTH - 1);
        { const Params P = fresh_params(); phase_norm(P, l, 0, l == 0); if (l == 0) convert_weights(P, 0, lds, 0); }
        xcd_barrier(bar);
        for (int rep = 0; rep < REP_G1; ++rep) {
        { const Params P = fresh_params(); const int G = gridDim.x, blk = blockIdx.x;
          pg8::Gemm g{(const pg8::bf16_t*)(P.ws + WS_H), (const pg8::bf16_t*)(P.ws + (size_t)(l & 1) * WS_WBUF + WS_W), ROWS, INW, DM}; pg8::StaticOrder S; S.init(ROWS, INW, G, blk);
          pg8::EpiBf16<0> E{(pg8::bf16_t*)(P.ws + WS_PROJ), INW, nullptr, 0, 0, 1.0f};
          pg8::gemm_phase<pg8::EpiBf16<0>, pg8::StaticOrder, true, true>(ldsl, g, S, E); }
        xcd_barrier(bar);
        }
        { const Params P = fresh_params(); phase_prep(P, l, lds); }
        xcd_barrier(bar);
#ifdef PROBE_HG
        { const Params P = fresh_params(); if (blockIdx.x < 128) hgrn_unit(P, l, ldsl, blockIdx.x >> 3, (blockIdx.x >> 1) & 3, blockIdx.x & 1); }
        xcd_barrier(bar);
#endif
        for (int rep = 0; rep < REP_MIX; ++rep) { { const Params P = fresh_params(); phase_mix(P, l, lds, rep); }
        xcd_barrier(bar); }
        { const Params P = fresh_params(); phase_hfin(P, l); }
        xcd_barrier(bar);
#ifdef PROBE_HF
        { const Params P = fresh_params(); phase_hfin(P, l); }
        xcd_barrier(bar);
#endif
#ifdef PROBE_SYNC
        for (int i = 0; i < 10; ++i) xcd_barrier(bar);
#endif
        { const Params P = fresh_params(); const int G = gridDim.x, blk = blockIdx.x;
          const float* modl = (const float*)(P.ws + WS_MOD) + (size_t)l * 17 * MODW;
          pg8::Gemm g{(const pg8::bf16_t*)(P.ws + WS_H), (const pg8::bf16_t*)(P.ws + (size_t)(l & 1) * WS_WBUF + WS_W_OUT), ROWS, DM, DM};
          EpiResid E{P.out, (float*)(P.ws + WS_XC), modl + 2 * DM};
          if (lat_only) { LatOrder S; S.init(DM, G, blk); pg8::gemm_phase<EpiResid, LatOrder, RES_ALIGN, true>(ldsl, g, S, E); }
          else { pg8::StaticOrder S; S.init(ROWS, DM, G, blk); pg8::gemm_phase<EpiResid, pg8::StaticOrder, RES_ALIGN, true>(ldsl, g, S, E); } }
        xcd_barrier(bar);
        { const Params P = fresh_params(); phase_norm(P, l, 1, false); }
        xcd_barrier(bar);
#ifdef PROBE_N2
        { const Params P = fresh_params(); phase_norm(P, l, 1, false); }
        xcd_barrier(bar);
#endif
        for (int rep = 0; rep < REP_G3; ++rep) {
        { const Params P = fresh_params(); const int G = gridDim.x, blk = blockIdx.x;
          pg8::Gemm g{(const pg8::bf16_t*)(P.ws + WS_H), (const pg8::bf16_t*)(P.ws + (size_t)(l & 1) * WS_WBUF + WS_W_FI), ROWS, 2 * FFH, DM};
          EpiSwiGLU E{(bf16_t*)(P.ws + WS_PROJ)};
          if (lat_only) { LatOrder S; S.init(2 * FFH, G, blk); pg8::gemm_phase<EpiSwiGLU, LatOrder, true, true>(ldsl, g, S, E); }
          else { pg8::StaticOrder S; S.init(ROWS, 2 * FFH, G, blk); pg8::gemm_phase<EpiSwiGLU, pg8::StaticOrder, true, true>(ldsl, g, S, E); } }
        xcd_barrier(bar);
        }
        { const Params P = fresh_params(); const int G = gridDim.x, blk = blockIdx.x;
          const float* modl = (const float*)(P.ws + WS_MOD) + (size_t)l * 17 * MODW;
          pg8::Gemm g{(const pg8::bf16_t*)(P.ws + WS_PROJ), (const pg8::bf16_t*)(P.ws + (size_t)(l & 1) * WS_WBUF + WS_W_FO), ROWS, DM, FFH};
          EpiResid E{P.out, (float*)(P.ws + WS_XC), modl + 5 * DM};
          if (lat_only) { LatOrder S; S.init(DM, G, blk); pg8::gemm_phase<EpiResid, LatOrder, RES_ALIGN, true>(ldsl, g, S, E); }
          else { pg8::StaticOrder S; S.init(ROWS, DM, G, blk); pg8::gemm_phase<EpiResid, pg8::StaticOrder, RES_ALIGN, true>(ldsl, g, S, E); }
          if (l + 1 < DEPTH) { __syncthreads(); convert_weights(P, l + 1, lds, lat_only ? 0 : 64); } }
        xcd_barrier(bar);
    }
    { const Params P = fresh_params(); phase_final(P); }
}

extern "C" void kernel_launch(void* const* d_in, const int* in_sizes, int n_in, void* d_out, int out_size, void* d_ws, size_t ws_size, hipStream_t stream) {
    static int grid = 0;
    if (grid == 0) {
        if (n_in != 19 || ws_size < WS_END) { fprintf(stderr, "kernel_launch: unexpected n_in %d / ws_size %zu\n", n_in, ws_size); grid = -1; return; }
        int dev = 0, cus = 0, per_cu = 0;
        (void)hipGetDevice(&dev);
        (void)hipDeviceGetAttribute(&cus, hipDeviceAttributeMultiprocessorCount, dev);
        (void)hipFuncSetAttribute((const void*)hybrid_fwd, hipFuncAttributeMaxDynamicSharedMemorySize, LDS_BYTES);
        (void)hipOccupancyMaxActiveBlocksPerMultiprocessor(&per_cu, (const void*)hybrid_fwd, 512, LDS_BYTES);
        if (per_cu < 1) { fprintf(stderr, "kernel_launch: occupancy query says %d blocks per CU\n", per_cu); per_cu = 1; }
        grid = cus * 1;
        (void)hipGetLastError();
    }
    if (grid < 0) return;
    Params p{};
    const float** pp = (const float**)&p;
    for (int i = 0; i < 19; ++i) pp[i] = (const float*)d_in[i];
    p.out = (float*)d_out; p.ws = (unsigned char*)d_ws;
    void* args[] = {&p};
    hipError_t e = hipLaunchCooperativeKernel((const void*)hybrid_fwd, dim3(grid), dim3(512), args, LDS_BYTES, stream);
    if (e != hipSuccess) fprintf(stderr, "cooperative launch failed: %s (grid %d)\n", hipGetErrorString(e), grid);
}
```

```cpp
#include <hip/hip_runtime.h>
#include <hip/hip_cooperative_groups.h>
#include <cstdio>
#include <cstdint>
namespace cg = cooperative_groups;
namespace pg8 {
#define PG8_LAS __attribute__((address_space(3)))
typedef unsigned short bf16_t;
typedef short bf16x8 __attribute__((ext_vector_type(8)));
typedef float f32x4 __attribute__((ext_vector_type(4)));
typedef unsigned u32x4 __attribute__((ext_vector_type(4)));
constexpr int BM = 256, BK = 64, HALF = 128, HTB = HALF * BK * 2  , STAGE_BYTES = 8 * HTB, NXCD = 8, WGM = 4;

__host__ __device__ __forceinline__ int lds_byte(int r, int c) { const int st = (r >> 4) * 2 + (c >> 5), rr = r & 15, cc = c & 31, ob = rr * 64 + cc * 2; return st * 1024 + (ob ^ (((ob >> 9) & 1) << 5)); }
__host__ __device__ __forceinline__ void stage_rc(int b, int& R, int& C) { const int st = b / 1024, sb = b % 1024, swz = sb ^ (((sb >> 9) & 1) << 5); R = (st >> 1) * 16 + swz / 64; C = (st & 1) * 32 + (swz % 64) / 2; }
__host__ __device__ __forceinline__ int perm32(int rho) { const int n = rho >> 4, i = rho & 15; return 8 * (i >> 2) + 4 * n + (i & 3); }

struct Unit { int pm, pn; };
struct Gemm { const bf16_t* A; const bf16_t* Bt; int M, N, K; };

struct StaticOrder {
    int nM, nN, nwg, G, c;
    __host__ __device__ void init(int M, int N, int G_, int c_) { nM = M / BM; nN = N / BM; nwg = nM * nN; G = G_; c = c_; }
    __host__ __device__ bool next(int i, Unit& u) const {
        const long L = (long)i * G + c; if (L >= nwg) return false;
        int wgid = (int)L; { const int q = nwg / NXCD, r = nwg % NXCD, xcd = wgid % NXCD, off = wgid / NXCD; wgid = (xcd < r ? xcd * (q + 1) : r * (q + 1) + (xcd - r) * q) + off; }
        const int nig = WGM * nN, gid = wgid / nig, fm = gid * WGM, gsz = (nM - fm) < WGM ? (nM - fm) : WGM;
        u.pm = fm + ((wgid % nig) % gsz); u.pn = (wgid % nig) / gsz; return true;
    }
    __device__ __forceinline__ void a_ready(const Unit&) const {}
    __device__ __forceinline__ void done(const Unit&) const {}
};

__device__ __forceinline__ unsigned cvt_pk_bf16(float lo, float hi) { unsigned r; asm volatile("v_cvt_pk_bf16_f32 %0, %1, %2" : "=v"(r) : "v"(lo), "v"(hi)); return r; }
typedef float f32x2 __attribute__((ext_vector_type(2)));
__device__ __forceinline__ f32x2 gelu_pk(f32x2 v) {
    const f32x2 av = __builtin_elementwise_abs(v), d = av * 0.2316418882f + 1.0f;
    f32x2 t; t.x = __builtin_amdgcn_rcpf(d.x); t.y = __builtin_amdgcn_rcpf(d.y);
    f32x2 q = t * 0.5307027145f + (-0.7265760135f); q = q * t + 0.7107068705f; q = q * t + (-0.142248368f); q = q * t + 0.127414796f; q = q * t;
    const f32x2 s = (v * v) * (-0.72134752044f);
    f32x2 e; e.x = __builtin_amdgcn_exp2f(s.x); e.y = __builtin_amdgcn_exp2f(s.y);
    const f32x2 m = v * (q * e), r = v - m;
    f32x2 o; o.x = v.x < 0.f ? m.x : r.x; o.y = v.y < 0.f ? m.y : r.y; return o;
}

template <int ACT  > struct EpiBf16 {
    static constexpr bool PERM = true, AFTER_DRAIN = false; static_assert(ACT == 0 || ACT == 1, "EpiBf16: ACT is 0 (none) or 1 (gelu_pk)");
    bf16_t* O; int ldc; const float* bias; int split_cols; size_t split_stride; float scale0;
    __device__ __forceinline__ void operator()(const f32x4 (&acc)[2][2][4][2], const Unit& u, int wr, int wc, int fr, int fq) const {
        const int row0 = u.pm * BM + wr * 64 + fr; int colt = u.pn * BM; bf16_t* base = O;
        float sc = 1.f; if (split_cols) { const int t = colt / split_cols; base += (size_t)t * split_stride; colt -= t * split_cols; if (t == 0) sc = scale0; }
        const int col0 = colt + wc * 32 + 8 * fq, bcol0 = u.pn * BM + wc * 32 + 8 * fq;
        f32x4 bv[2][2];
#pragma unroll
        for (int bj = 0; bj < 2; ++bj)
#pragma unroll
            for (int n = 0; n < 2; ++n) bv[bj][n] = bias ? *(const f32x4*)(bias + bcol0 + bj * HALF + 4 * n) : (f32x4){0.f, 0.f, 0.f, 0.f};
#pragma unroll
        for (int ai = 0; ai < 2; ++ai)
#pragma unroll
            for (int m = 0; m < 4; ++m) { bf16_t* rowp = base + (size_t)(row0 + ai * HALF + m * 16) * ldc + col0;
#pragma unroll
                for (int bj = 0; bj < 2; ++bj) { f32x4 v0 = acc[ai][bj][m][0] + bv[bj][0], v1 = acc[ai][bj][m][1] + bv[bj][1];
                    if (ACT == 1) { f32x2 a = gelu_pk((f32x2){v0[0], v0[1]}), b = gelu_pk((f32x2){v0[2], v0[3]}), c = gelu_pk((f32x2){v1[0], v1[1]}), d = gelu_pk((f32x2){v1[2], v1[3]});
                        v0 = (f32x4){a.x, a.y, b.x, b.y}; v1 = (f32x4){c.x, c.y, d.x, d.y}; }
                    v0 = v0 * sc; v1 = v1 * sc; u32x4 w; w.x = cvt_pk_bf16(v0[0], v0[1]); w.y = cvt_pk_bf16(v0[2], v0[3]); w.z = cvt_pk_bf16(v1[0], v1[1]); w.w = cvt_pk_bf16(v1[2], v1[3]);
                    *(u32x4*)(rowp + bj * HALF) = w; } }
    }
};
template <class Epi, class Sched, bool ALIGN_EPI = false, bool SP2 = false>
__device__ __forceinline__ void gemm_phase(PG8_LAS unsigned char* lds, const Gemm g, const Sched& S, const Epi& E) {
    int tid_o = threadIdx.x; asm volatile("" : "+v"(tid_o));
    const int tid = tid_o, wid = __builtin_amdgcn_readfirstlane(tid >> 6), lane = tid & 63, wr = wid >> 2, wc = wid & 3, fr = lane & 15, fq = lane >> 4;
    const int K = g.K, nt = K / BK;
    unsigned voffA[2], voffB[2];
#pragma unroll
    for (int i = 0; i < 2; ++i) { int R, C; stage_rc(tid * 16 + i * 8192, R, C); const int Rb = Epi::PERM ? ((R & ~31) + perm32(R & 31)) : R;
        voffA[i] = (unsigned)(R * K + C) * 2u; voffB[i] = (unsigned)(Rb * K + C) * 2u; }
    const size_t kstep = (size_t)(BK * 2);
    const size_t hstep = (size_t)HALF * K * 2;
    const size_t tstep = 2 * hstep;
    const unsigned ldsw = (unsigned)wid * 1024u;
    const int aoff = lds_byte(wr * 64 + fr, fq * 8), boff = lds_byte(wc * 32 + fr, fq * 8);
#define PG8_SA(b, h) (((b) * 2 + (h)) * HTB)
#define PG8_SB(b, h) ((4 + (b) * 2 + (h)) * HTB)
#define PG8_STAGE(bufoff, gbase, voff) do { _Pragma("unroll") for (int _i = 0; _i < 2; ++_i) \
        __builtin_amdgcn_global_load_lds((const unsigned*)((const char*)(gbase) + (voff)[_i]), (PG8_LAS unsigned*)(lds + (bufoff) + ldsw + _i * 8192), 16, 0, 0); } while (0)
#define PG8_LDA(dst, b, h) do { _Pragma("unroll") for (int m = 0; m < 4; ++m) _Pragma("unroll") for (int k = 0; k < 2; ++k) dst[m][k] = *(const PG8_LAS bf16x8*)(lds + PG8_SA(b, h) + aoff + m * 2048 + k * 1024); } while (0)
#define PG8_LDB(dst, b, h) do { _Pragma("unroll") for (int n = 0; n < 2; ++n) _Pragma("unroll") for (int k = 0; k < 2; ++k) dst[n][k] = *(const PG8_LAS bf16x8*)(lds + PG8_SB(b, h) + boff + n * 2048 + k * 1024); } while (0)
#define PG8_MMA(ai, bj, At, Bt) do { __builtin_amdgcn_s_setprio(1); _Pragma("unroll") for (int m = 0; m < 4; ++m) _Pragma("unroll") for (int n = 0; n < 2; ++n) _Pragma("unroll") for (int k = 0; k < 2; ++k) \
        acc[ai][bj][m][n] = __builtin_amdgcn_mfma_f32_16x16x32_bf16(Bt[n][k], At[m][k], acc[ai][bj][m][n], 0, 0, 0); __builtin_amdgcn_s_setprio(0); } while (0)
#define PG8_WAIT_V(n) asm volatile("s_waitcnt vmcnt(" #n ")" ::: "memory")
#define PG8_WAIT_L(n) asm volatile("s_waitcnt lgkmcnt(" #n ")" ::: "memory")
#define PG8_BAR __builtin_amdgcn_s_barrier()
#define PG8_SCHED __builtin_amdgcn_sched_barrier(0)
    Unit cur, nxt; int ui = 0;
    if (!S.next(0, cur)) return;
    f32x4 acc[2][2][4][2];
#pragma unroll
    for (int a = 0; a < 2; ++a)
#pragma unroll
        for (int b = 0; b < 2; ++b)
#pragma unroll
            for (int m = 0; m < 4; ++m)
#pragma unroll
                for (int n = 0; n < 2; ++n) acc[a][b][m][n] = (f32x4){0.f, 0.f, 0.f, 0.f};
    bf16x8 At[4][2], B0[2][2], B1[2][2];
    const char* cA = (const char*)g.A + (size_t)cur.pm * tstep; const char* cB = (const char*)g.Bt + (size_t)cur.pn * tstep;
    S.a_ready(cur);
    if constexpr (SP2) {
        PG8_STAGE(PG8_SB(0, 0), cB, voffB); PG8_STAGE(PG8_SB(0, 1), cB + hstep, voffB); PG8_STAGE(PG8_SA(0, 0), cA, voffA); PG8_STAGE(PG8_SA(0, 1), cA + hstep, voffA);
        if (wr == 1) PG8_BAR;
        PG8_WAIT_V(2); PG8_BAR;
        PG8_STAGE(PG8_SB(1, 0), cB + kstep, voffB); PG8_STAGE(PG8_SA(1, 0), cA + kstep, voffA); PG8_STAGE(PG8_SB(1, 1), cB + hstep + kstep, voffB);
        PG8_WAIT_V(6); PG8_BAR;
    } else {
        PG8_STAGE(PG8_SB(0, 0), cB, voffB); PG8_STAGE(PG8_SA(0, 0), cA, voffA); PG8_STAGE(PG8_SB(0, 1), cB + hstep, voffB); PG8_STAGE(PG8_SA(0, 1), cA + hstep, voffA);
        if (wr == 1) PG8_BAR;
        PG8_WAIT_V(4); PG8_BAR;
        PG8_STAGE(PG8_SB(1, 0), cB + kstep, voffB); PG8_STAGE(PG8_SA(1, 0), cA + kstep, voffA); PG8_STAGE(PG8_SB(1, 1), cB + hstep + kstep, voffB);
        PG8_WAIT_V(6); PG8_BAR;
    }
    for (;;) {
        const bool has_next = S.next(ui + 1, nxt);
        const char* nA = has_next ? (const char*)g.A + (size_t)nxt.pm * tstep : cA; const char* nB = has_next ? (const char*)g.Bt + (size_t)nxt.pn * tstep : cB;
        for (int t = 0; t < nt; t += 2) {
            const bool last = (t == nt - 2);
            const char* a1 = cA + (size_t)(t + 1) * kstep;
            const char* a2 = last ? nA : cA + (size_t)(t + 2) * kstep; const char* b2 = last ? nB : cB + (size_t)(t + 2) * kstep;
            const char* a3 = a2 + kstep; const char* b3 = b2 + kstep;
            if (last && has_next) S.a_ready(nxt);
            if constexpr (SP2) {
            PG8_LDB(B0, 0, 0); PG8_LDB(B1, 0, 1); PG8_SCHED; PG8_LDA(At, 0, 0); PG8_STAGE(PG8_SA(1, 1), a1 + hstep, voffA);
            PG8_WAIT_V(8); PG8_WAIT_L(0); PG8_BAR; PG8_MMA(0, 0, At, B0); PG8_MMA(0, 1, At, B1); PG8_BAR; PG8_SCHED;
            PG8_LDA(At, 0, 1); PG8_STAGE(PG8_SB(0, 0), b2, voffB); PG8_STAGE(PG8_SB(0, 1), b2 + hstep, voffB); PG8_STAGE(PG8_SA(0, 0), a2, voffA);
            PG8_WAIT_V(8); PG8_WAIT_L(0); PG8_BAR; PG8_MMA(1, 0, At, B0); PG8_MMA(1, 1, At, B1); PG8_BAR; PG8_SCHED;
            PG8_LDB(B0, 1, 0); PG8_LDB(B1, 1, 1); PG8_SCHED; PG8_LDA(At, 1, 0); PG8_STAGE(PG8_SA(0, 1), a2 + hstep, voffA);
            PG8_WAIT_V(8); PG8_WAIT_L(0); PG8_BAR; PG8_MMA(0, 0, At, B0); PG8_MMA(0, 1, At, B1); PG8_BAR; PG8_SCHED;
            PG8_LDA(At, 1, 1); PG8_STAGE(PG8_SB(1, 0), b3, voffB); PG8_STAGE(PG8_SB(1, 1), b3 + hstep, voffB); PG8_STAGE(PG8_SA(1, 0), a3, voffA);
            PG8_WAIT_V(8); PG8_WAIT_L(0); PG8_BAR; PG8_MMA(1, 0, At, B0); PG8_MMA(1, 1, At, B1); PG8_BAR; PG8_SCHED;
            } else {
            PG8_LDB(B0, 0, 0); PG8_SCHED; PG8_LDA(At, 0, 0); PG8_STAGE(PG8_SA(1, 1), a1 + hstep, voffA);
            PG8_WAIT_L(8); PG8_BAR; PG8_WAIT_L(0); PG8_MMA(0, 0, At, B0); PG8_BAR; PG8_SCHED;
            PG8_LDB(B1, 0, 1); PG8_STAGE(PG8_SB(0, 0), b2, voffB);
            PG8_BAR; PG8_WAIT_L(0); PG8_MMA(0, 1, At, B1); PG8_BAR;
            PG8_LDA(At, 0, 1); PG8_STAGE(PG8_SA(0, 0), a2, voffA);
            PG8_BAR; PG8_WAIT_L(0); PG8_MMA(1, 0, At, B0); PG8_BAR; PG8_SCHED;
            PG8_STAGE(PG8_SB(0, 1), b2 + hstep, voffB);
            PG8_WAIT_V(6); PG8_BAR; PG8_MMA(1, 1, At, B1); PG8_BAR;
            PG8_LDB(B0, 1, 0); PG8_SCHED; PG8_LDA(At, 1, 0); PG8_STAGE(PG8_SA(0, 1), a2 + hstep, voffA);
            PG8_WAIT_L(8); PG8_BAR; PG8_WAIT_L(0); PG8_MMA(0, 0, At, B0); PG8_BAR; PG8_SCHED;
            PG8_LDB(B1, 1, 1); PG8_STAGE(PG8_SB(1, 0), b3, voffB);
            PG8_BAR; PG8_WAIT_L(0); PG8_MMA(0, 1, At, B1); PG8_BAR;
            PG8_LDA(At, 1, 1); PG8_STAGE(PG8_SA(1, 0), a3, voffA);
            PG8_BAR; PG8_WAIT_L(0); PG8_MMA(1, 0, At, B0); PG8_BAR; PG8_SCHED;
            PG8_STAGE(PG8_SB(1, 1), b3 + hstep, voffB);
            PG8_WAIT_V(6); PG8_BAR; PG8_MMA(1, 1, At, B1); PG8_BAR;
            }
        }
        if constexpr (ALIGN_EPI) { if (wr == 0) PG8_BAR; }
        if constexpr (!Epi::AFTER_DRAIN) { E(acc, cur, wr, wc, fr, fq); S.done(cur); }
        if (!has_next) break;
#pragma unroll
        for (int a = 0; a < 2; ++a)
#pragma unroll
            for (int b = 0; b < 2; ++b)
#pragma unroll
                for (int m = 0; m < 4; ++m)
#pragma unroll
                    for (int n = 0; n < 2; ++n) acc[a][b][m][n] = (f32x4){0.f, 0.f, 0.f, 0.f};
        cur = nxt; cA = nA; cB = nB; ++ui;
        if constexpr (ALIGN_EPI) { if (wr == 1) PG8_BAR; }
    }
    PG8_WAIT_V(0);
    if constexpr (!ALIGN_EPI) { if (wr == 0) PG8_BAR; }
    PG8_BAR;
    if constexpr (Epi::AFTER_DRAIN) { E.fused(acc, cur, wr, wc, fr, fq, lds, wid, lane); S.done(cur); }
#undef PG8_SA
#undef PG8_SB
#undef PG8_STAGE
#undef PG8_LDA
#undef PG8_LDB
#undef PG8_MMA
#undef PG8_WAIT_V
#undef PG8_WAIT_L
#undef PG8_BAR
#undef PG8_SCHED
}
}

#define LAS __attribute__((address_space(3)))
typedef unsigned short bf16_t;
typedef short bf16x8 __attribute__((ext_vector_type(8)));
typedef float f32x4 __attribute__((ext_vector_type(4)));
typedef float f32x16 __attribute__((ext_vector_type(16)));
typedef unsigned u32x4 __attribute__((ext_vector_type(4)));
typedef unsigned u32x2 __attribute__((ext_vector_type(2)));

constexpr int DM = 1024, NBATCH = 16, SEQ = 2048, CTX = 256, TT = SEQ + CTX  , ROWS = NBATCH * TT  ;
constexpr int INW = 2816, FFH = 2816, DEPTH = 4, MODW = 6 * DM;
constexpr float RMS_EPS = 1e-6f;
constexpr float LOG2E = 1.4426950408889634f;
constexpr int PA_Q = 0, PA_K = 256, PA_V = 512, PB_Q = 768, PB_FF = 1024, PB_FB = 1280, PB_I = 1536, PB_G = 1792, PC_Q = 2048, PC_K = 2304, PC_V = 2432, PD_U = 2560;

constexpr size_t MiB = 1u << 20;
constexpr size_t WS_CTL = 0;
constexpr size_t WS_MOD = 1 * MiB;
constexpr size_t WS_W = 4 * MiB, WS_WBUF = 24 * MiB;
constexpr size_t WS_W_OUT = WS_W + (size_t)INW * DM * 2, WS_W_FI = WS_W_OUT + (size_t)DM * DM * 2, WS_W_FO = WS_W_FI + (size_t)2 * FFH * DM * 2;
constexpr size_t WS_FMAT = 52 * MiB;
constexpr size_t WS_FC = 68 * MiB;
constexpr size_t WS_XC = 69 * MiB;
constexpr size_t WS_H = 85 * MiB;
constexpr size_t WS_PROJ = 157 * MiB;
constexpr size_t WS_VTA = 355 * MiB;
constexpr size_t WS_VTC = 373 * MiB;
constexpr size_t WS_ZT = 382 * MiB;
constexpr size_t WS_ZCT = 414 * MiB;
constexpr size_t WS_ODIR = 418 * MiB;
constexpr size_t WS_END = 490 * MiB;
static_assert(WS_W_FO + (size_t)DM * FFH * 2 <= WS_W + WS_WBUF && WS_W + 2 * WS_WBUF <= WS_FMAT, "weights fit");
constexpr int CW_QUEUE = 0;
constexpr int CW_LAM = 1024;
constexpr int CW_LB = 2048;
constexpr int CW_BAR = 4096, XCD_BAR_WORDS_C = 3456;

constexpr int LDS_RING = 131072, LDS_MISC = LDS_RING, LDS_BYTES = 147456;

struct Params {
    const float *x, *c, *ctx, *c_ctx, *w_mod, *b_mod, *norm1, *w_in, *diff_lambda, *diff_norm, *lb_logits, *hgrn_norm, *q_norm, *k_norm, *w_out, *norm2, *w_ffn_in, *w_ffn_out, *final_norm;
    float* out; unsigned char* ws;
};

__device__ __forceinline__ int opaque_tid() { int t = threadIdx.x; asm volatile("" : "+v"(t)); return t; }
__device__ __forceinline__ unsigned f2bf(float f) { unsigned u = __builtin_bit_cast(unsigned, f); return (u + 0x7fffu + ((u >> 16) & 1u)) >> 16; }
typedef float f32x2_t __attribute__((ext_vector_type(2))); typedef __bf16 bf16x2_t __attribute__((ext_vector_type(2)));
__device__ __forceinline__ unsigned pk2(float lo, float hi) { f32x2_t v = {lo, hi}; bf16x2_t b = __builtin_convertvector(v, bf16x2_t); return __builtin_bit_cast(unsigned, b); }
__device__ __forceinline__ float bf2f(unsigned h) { return __builtin_bit_cast(float, h << 16); }
__device__ __forceinline__ float bflo(unsigned w) { return __builtin_bit_cast(float, w << 16); }
__device__ __forceinline__ float bfhi(unsigned w) { return __builtin_bit_cast(float, w & 0xffff0000u); }
__device__ __forceinline__ float shx(float v, int o, int lane) { return __builtin_bit_cast(float, __builtin_amdgcn_ds_bpermute((lane ^ o) << 2, __builtin_bit_cast(int, v))); }
__device__ __forceinline__ float wave_sum(float v, int lane) {
#pragma unroll
    for (int o = 1; o < 64; o <<= 1) v += shx(v, o, lane);
    return v;
}
__device__ __forceinline__ float fast_exp2(float x) { return __builtin_amdgcn_exp2f(x); }
__device__ __forceinline__ float sigmoidf_(float z) { return __builtin_amdgcn_rcpf(1.0f + fast_exp2(-z * LOG2E)); }

__device__ __forceinline__ float* xrow_ptr(const Params& P, int r) {
    const int b = r / TT, t = r - b * TT;
    return (t < CTX) ? (float*)(P.ws + WS_XC) + ((size_t)b * CTX + t) * DM : P.out + ((size_t)b * SEQ + (t - CTX)) * DM;
}

struct EpiResid {
    static constexpr bool PERM = false, AFTER_DRAIN = false;
    float* out; float* xc; const float* gate;
    __device__ __forceinline__ void operator()(const pg8::f32x4 (&acc)[2][2][4][2], const pg8::Unit& u, int wr, int wc, int fr, int fq) const {
        const int b = u.pm / 9, j = u.pm - b * 9;
        float* base = (j == 0) ? xc + (size_t)b * CTX * DM : out + ((size_t)b * SEQ + (size_t)(j - 1) * 256) * DM;
        const float* g = gate + (size_t)((j == 0) ? 16 : b) * MODW;
        const int col0 = u.pn * 256 + wc * 32 + 4 * fq;
        pg8::f32x4 gv[2][2];
#pragma unroll
        for (int bj = 0; bj < 2; ++bj)
#pragma unroll
            for (int n = 0; n < 2; ++n) gv[bj][n] = *(const pg8::f32x4*)(g + col0 + bj * 128 + n * 16);
#pragma unroll
        for (int ai = 0; ai < 2; ++ai)
#pragma unroll
            for (int m = 0; m < 4; ++m) {
                float* rowp = base + (size_t)(ai * 128 + wr * 64 + m * 16 + fr) * DM + col0;
#pragma unroll
                for (int bj = 0; bj < 2; ++bj)
#pragma unroll
                    for (int n = 0; n < 2; ++n) {
                        pg8::f32x4* p = (pg8::f32x4*)(rowp + bj * 128 + n * 16);
                        pg8::f32x4 xv = *p; xv = xv + gv[bj][n] * acc[ai][bj][m][n]; *p = xv;
                    }
                if (m & 1) asm volatile("" ::: "memory");
            }
    }
};
struct EpiSwiGLU {
    static constexpr bool PERM = true, AFTER_DRAIN = false;
    bf16_t* O;
    __device__ __forceinline__ void operator()(const pg8::f32x4 (&acc)[2][2][4][2], const pg8::Unit& u, int wr, int wc, int fr, int fq) const {
        const int col0 = u.pn * 128 + wc * 32 + 8 * fq;
#pragma unroll
        for (int ai = 0; ai < 2; ++ai)
#pragma unroll
            for (int m = 0; m < 4; ++m) {
                bf16_t* rowp = O + (size_t)(u.pm * 256 + ai * 128 + wr * 64 + m * 16 + fr) * FFH + col0;
                float v[8];
#pragma unroll
                for (int n = 0; n < 2; ++n)
#pragma unroll
                    for (int e = 0; e < 4; ++e) { const float g = acc[ai][0][m][n][e], up = acc[ai][1][m][n][e]; v[n * 4 + e] = g * sigmoidf_(g) * up; }
                u32x4 w; w.x = pk2(v[0], v[1]); w.y = pk2(v[2], v[3]); w.z = pk2(v[4], v[5]); w.w = pk2(v[6], v[7]);
                *(u32x4*)rowp = w;
            }
    }
};
struct OneUnit {
    int pm, pn;
    __device__ bool next(int i, pg8::Unit& u) const { if (i != 0) return false; u.pm = pm; u.pn = pn; return true; }
    __device__ __forceinline__ void a_ready(const pg8::Unit&) const {}
    __device__ __forceinline__ void done(const pg8::Unit&) const {}
};
struct LatOrder {
    pg8::StaticOrder S;
    __device__ void init(int N, int G, int c) { S.init(NBATCH * SEQ, N, G, c); }
    __device__ bool next(int i, pg8::Unit& u) const { if (!S.next(i, u)) return false; u.pm = (u.pm >> 3) * 9 + 1 + (u.pm & 7); return true; }
    __device__ __forceinline__ void a_ready(const pg8::Unit&) const {}
    __device__ __forceinline__ void done(const pg8::Unit&) const {}
};

__device__ __forceinline__ void phase_init(const Params& P, unsigned char* lds) {
    const int tid = opaque_tid(), lane = tid & 63, wave = tid >> 6, G = gridDim.x, blk = blockIdx.x;
    unsigned* ctl = (unsigned*)(P.ws + WS_CTL);
    if (blk == 0) { if (tid < 4 * DEPTH) ctl[CW_QUEUE + 64 * tid] = 0u; for (int i = tid; i < XCD_BAR_WORDS_C; i += 512) ctl[CW_BAR + i] = 0u; }
    if (blk == 1 % G) {
        float* lbv = (float*)ctl + CW_LB;
        { const int dir = tid >> 8, j = tid & 255; float z[DEPTH], mx = -1e30f;
#pragma unroll
          for (int l = 0; l < DEPTH; ++l) { z[l] = P.lb_logits[((size_t)dir * DEPTH + l) * 256 + j]; mx = fmaxf(mx, z[l]); }
          float s = 0.f;
#pragma unroll
          for (int l = 0; l < DEPTH; ++l) { z[l] = __expf(z[l] - mx); s += z[l]; }
          float cum = 0.f; const float inv = 1.0f / s;
#pragma unroll
          for (int l = 0; l < DEPTH; ++l) { if (l > 0) cum += z[l] * inv; lbv[((size_t)dir * DEPTH + l) * 256 + j] = cum; } }
        if (wave < DEPTH) { const int l = wave; const float* lp = P.diff_lambda + (size_t)l * 128;
            float a = (lane < 32) ? lp[lane] * lp[32 + lane] : 0.f, b2 = (lane < 32) ? lp[64 + lane] * lp[96 + lane] : 0.f;
            a = wave_sum(a, lane); b2 = wave_sum(b2, lane);
            const float lam_init = 0.8f - 0.6f * expf(-0.3f * (float)l);
            if (lane == 0) { ((float*)ctl)[CW_LAM + l] = expf(a) - expf(b2) + lam_init; ((float*)ctl)[CW_LAM + 8 + l] = 1.0f - lam_init; } }
    }
    float* sc = (float*)lds;
    for (int i = tid; i < 17 * DM; i += 512) { const int bb = i >> 10, k = i & 1023; const float v = (bb < 16) ? P.c[(size_t)bb * DM + k] : P.c_ctx[k]; sc[i] = v * sigmoidf_(v); }
    __syncthreads();
    float* red = (float*)(lds + 17 * DM * 4);
    float* mod = (float*)(P.ws + WS_MOD);
    for (int it = blk; it < DEPTH * (MODW / 64); it += G) {
        const int l = it / (MODW / 64), n0 = (it % (MODW / 64)) * 64;
        const float* W = P.w_mod + (size_t)l * DM * MODW + n0 + lane;
        float acc[17];
#pragma unroll
        for (int bb = 0; bb < 17; ++bb) acc[bb] = 0.f;
        for (int k = wave * 128; k < wave * 128 + 128; k += 4) {
            const float w0 = W[(size_t)k * MODW], w1 = W[(size_t)(k + 1) * MODW], w2 = W[(size_t)(k + 2) * MODW], w3 = W[(size_t)(k + 3) * MODW];
#pragma unroll
            for (int bb = 0; bb < 17; ++bb) { const f32x4 s4 = *(const f32x4*)(sc + bb * DM + k); acc[bb] += s4.x * w0 + s4.y * w1 + s4.z * w2 + s4.w * w3; }
        }
#pragma unroll
        for (int bb = 0; bb < 17; ++bb) red[(wave * 17 + bb) * 64 + lane] = acc[bb];
        __syncthreads();
        for (int i = tid; i < 17 * 64; i += 512) { const int bb = i >> 6, n = i & 63; float s = 0.f;
#pragma unroll
            for (int w = 0; w < 8; ++w) s += red[(w * 17 + bb) * 64 + n];
            mod[((size_t)l * 17 + bb) * MODW + n0 + n] = s + P.b_mod[(size_t)l * MODW + n0 + n]; }
        __syncthreads();
    }
    {
        bf16_t* F = (bf16_t*)(P.ws + WS_FMAT);
        const float sc1 = 0.022097086912079608f;
        for (int i = blk * 512 + tid; i < 2048 * 2048 / 8; i += G * 512) {
            const int tp = i >> 8, k0 = (i & 255) * 8; float v[8];
#pragma unroll
            for (int j = 0; j < 8; ++j) { const int k = k0 + j; const int kk = k & 1023; const float rev = (float)((tp * kk) & 2047) * (1.0f / 2048.0f);
                v[j] = (k < 1024) ? __builtin_amdgcn_cosf(rev) * sc1 : ((k == 1024) ? ((tp & 1) ? -sc1 : sc1) : -__builtin_amdgcn_sinf(rev) * sc1); }
            u32x4 w; w.x = pk2(v[0], v[1]); w.y = pk2(v[2], v[3]); w.z = pk2(v[4], v[5]); w.w = pk2(v[6], v[7]);
            *(u32x4*)(F + (size_t)i * 8) = w;
        }
        bf16_t* Fc = (bf16_t*)(P.ws + WS_FC);
        for (int i = blk * 512 + tid; i < 256 * 512 / 8; i += G * 512) {
            const int tp = i >> 6, k0 = (i & 63) * 8; float v[8];
#pragma unroll
            for (int j = 0; j < 8; ++j) { const int k = k0 + j; const int kk = k & 255; const float rev = (float)((tp * kk) & 255) * (1.0f / 256.0f);
                v[j] = (k < 256) ? __builtin_amdgcn_cosf(rev) * 0.0625f : -__builtin_amdgcn_sinf(rev) * 0.0625f; }
            u32x4 w; w.x = pk2(v[0], v[1]); w.y = pk2(v[2], v[3]); w.z = pk2(v[4], v[5]); w.w = pk2(v[6], v[7]);
            *(u32x4*)(Fc + (size_t)i * 8) = w;
        }
    }
}

__device__ __forceinline__ void transpose_item(const float* W, int K, int N, bf16_t* WT, int mode, float* scr, int item, int lane) {
    const int nblk = N / 32, kb = item / nblk, nb = item % nblk, k0 = 64 * kb, n0 = 32 * nb;
    int r0 = n0;
    if (mode == 1) { r0 = (n0 < FFH) ? (n0 / 128) * 256 + (n0 % 128) : ((n0 - FFH) / 128) * 256 + 128 + ((n0 - FFH) % 128); }
#pragma unroll 8
    for (int i = 0; i < 32; ++i) { const int kk = 2 * i + (lane >> 5); scr[kk * 33 + (lane & 31)] = W[(size_t)(k0 + kk) * N + n0 + (lane & 31)]; }
    asm volatile("s_waitcnt lgkmcnt(0)" ::: "memory");
    const int c = lane & 7;
#pragma unroll
    for (int j = 0; j < 4; ++j) { const int n = (lane >> 3) + 8 * j; const float* s = scr + (8 * c) * 33 + n;
        u32x4 o; o.x = pk2(s[0 * 33], s[1 * 33]); o.y = pk2(s[2 * 33], s[3 * 33]); o.z = pk2(s[4 * 33], s[5 * 33]); o.w = pk2(s[6 * 33], s[7 * 33]);
        *(u32x4*)(WT + (size_t)(r0 + n) * K + k0 + 8 * c) = o; }
    asm volatile("s_waitcnt lgkmcnt(0)" ::: "memory");
}
__device__ __forceinline__ void convert_weights(const Params& P, int l, unsigned char* lds, int blk0) {
    const int tid = opaque_tid(), lane = tid & 63, wave = tid >> 6;
    if ((int)blockIdx.x < blk0) return;
    float* scr = (float*)(lds + wave * 16384);
    const int gw = ((int)blockIdx.x - blk0) * 8 + wave, NGW = ((int)gridDim.x - blk0) * 8;
    unsigned char* wb = P.ws + (size_t)(l & 1) * WS_WBUF;
    constexpr int I_IN = (DM / 64) * (INW / 32), I_OUT = (DM / 64) * (DM / 32), I_FI = (DM / 64) * (2 * FFH / 32), I_FO = (FFH / 64) * (DM / 32);
    for (int it = gw; it < I_IN + I_OUT + I_FI + I_FO; it += NGW) {
        int r = it;
        if (r < I_IN) { transpose_item(P.w_in + (size_t)l * DM * INW, DM, INW, (bf16_t*)(wb + WS_W), 0, scr, r, lane); continue; } r -= I_IN;
        if (r < I_OUT) { transpose_item(P.w_out + (size_t)l * DM * DM, DM, DM, (bf16_t*)(wb + WS_W_OUT), 0, scr, r, lane); continue; } r -= I_OUT;
        if (r < I_FI) { transpose_item(P.w_ffn_in + (size_t)l * DM * 2 * FFH, DM, 2 * FFH, (bf16_t*)(wb + WS_W_FI), 1, scr, r, lane); continue; } r -= I_FI;
        transpose_item(P.w_ffn_out + (size_t)l * FFH * DM, FFH, DM, (bf16_t*)(wb + WS_W_FO), 0, scr, r, lane);
    }
}

__device__ __forceinline__ void phase_norm(const Params& P, int l, int which, bool first) {
    const int tid = opaque_tid(), lane = tid & 63, wave = tid >> 6;
    const int gw = blockIdx.x * 8 + wave, NGW = gridDim.x * 8;
    const float* gain = (which == 0 ? P.norm1 : P.norm2) + (size_t)l * DM;
    const float* mod = (const float*)(P.ws + WS_MOD) + (size_t)l * 17 * MODW + (which == 0 ? 0 : 3 * DM);
    bf16_t* H = (bf16_t*)(P.ws + WS_H);
    for (int r = gw; r < ROWS; r += NGW) {
        const int b = r / TT, t = r - b * TT; const int bb = (t < CTX) ? 16 : b;
        float* xr = xrow_ptr(P, r);
        const float* src = first ? ((t < CTX) ? P.ctx + ((size_t)b * CTX + t) * DM : P.x + ((size_t)b * SEQ + (t - CTX)) * DM) : xr;
        f32x4 v[4]; float s2 = 0.f;
#pragma unroll
        for (int j = 0; j < 4; ++j) { v[j] = *((const f32x4*)src + lane + 64 * j); s2 += (v[j].x * v[j].x + v[j].y * v[j].y) + (v[j].z * v[j].z + v[j].w * v[j].w); }
        if (first) {
#pragma unroll
            for (int j = 0; j < 4; ++j) *((f32x4*)xr + lane + 64 * j) = v[j];
        }
        const float rstd = 1.0f / sqrtf(wave_sum(s2, lane) * (1.0f / DM) + RMS_EPS);
        const float* mrow = mod + (size_t)bb * MODW;
#pragma unroll
        for (int j = 0; j < 4; ++j) {
            const int c0 = 4 * (lane + 64 * j);
            const f32x4 g = *(const f32x4*)(gain + c0), sh = *(const f32x4*)(mrow + c0), scl = *(const f32x4*)(mrow + DM + c0);
            const f32x4 y = v[j] * rstd * g * (scl + 1.0f) + sh;
            u32x2 w; w.x = pk2(y.x, y.y); w.y = pk2(y.z, y.w);
            *(u32x2*)(H + (size_t)r * DM + c0) = w;
        }
    }
}
__device__ __forceinline__ void phase_final(const Params& P) {
    const int tid = opaque_tid(), lane = tid & 63, wave = tid >> 6;
    const int gw = blockIdx.x * 8 + wave, NGW = gridDim.x * 8;
    for (int r = gw; r < NBATCH * SEQ; r += NGW) {
        float* xr = P.out + (size_t)r * DM;
        f32x4 v[4]; float s2 = 0.f;
#pragma unroll
        for (int j = 0; j < 4; ++j) { v[j] = *((const f32x4*)xr + lane + 64 * j); s2 += (v[j].x * v[j].x + v[j].y * v[j].y) + (v[j].z * v[j].z + v[j].w * v[j].w); }
        const float rstd = 1.0f / sqrtf(wave_sum(s2, lane) * (1.0f / DM) + RMS_EPS);
#pragma unroll
        for (int j = 0; j < 4; ++j) { const f32x4 g = *((const f32x4*)P.final_norm + lane + 64 * j); *((f32x4*)xr + lane + 64 * j) = v[j] * rstd * g; }
    }
}

template <int NF> __device__ __forceinline__ void rope_half(float* v, int pos) {
#pragma unroll
    for (int i = 0; i < NF; ++i) {
        const float inv_freq = exp2f(-13.287712379549449f * (float)i / (float)NF);
        const float rev = (float)pos * inv_freq * 0.15915494309189535f;
        const float cs = __builtin_amdgcn_cosf(rev), sn = __builtin_amdgcn_sinf(rev);
        const float x1 = v[i], x2 = v[NF + i];
        v[i] = x1 * cs - x2 * sn; v[NF + i] = x2 * cs + x1 * sn;
    }
}
__device__ __forceinline__ void phase_prep(const Params& P, int l, unsigned char* lds) {
    const int G = gridDim.x;
    bf16_t* proj = (bf16_t*)(P.ws + WS_PROJ);
    for (int item = blockIdx.x; item < ROWS / 64 + NBATCH * 20; item += G) {
        const int tid = opaque_tid();
        const int type = item >= ROWS / 64;
        int r0, b, t0;
        if (!type) { r0 = item * 64; b = r0 / TT; t0 = r0 - b * TT; }
        else { const int idx = item - ROWS / 64; b = idx / 20; const int jb = idx - b * 20; t0 = (jb < 4) ? 64 * jb : CTX + 64 * (jb - 4); r0 = b * TT + t0; }
        const bool is_ctx = t0 < CTX;
        if (type == 0) {
#pragma unroll 1
            for (int rep = 0; rep < 2; ++rep) {
                const int id = tid + 512 * rep, tok = id >> 4, vv = id & 15; const bool isq = vv < 8;
                if (is_ctx && !isq) continue;
                bf16_t* p = proj + (size_t)(r0 + tok) * INW + (isq ? PA_Q + 32 * vv : PA_K + 32 * (vv - 8));
                u32x4 w[4]; float v[32];
#pragma unroll
                for (int j = 0; j < 4; ++j) { w[j] = *((const u32x4*)p + j);
                    v[8 * j + 0] = bflo(w[j].x); v[8 * j + 1] = bfhi(w[j].x); v[8 * j + 2] = bflo(w[j].y); v[8 * j + 3] = bfhi(w[j].y);
                    v[8 * j + 4] = bflo(w[j].z); v[8 * j + 5] = bfhi(w[j].z); v[8 * j + 6] = bflo(w[j].w); v[8 * j + 7] = bfhi(w[j].w); }
                if (!is_ctx) { const int tl = t0 - CTX + tok; rope_half<8>(v, tl >> 6); rope_half<8>(v + 16, tl & 63); }
                const float sc = isq ? 0.17677669529663687f * LOG2E : 1.0f;
#pragma unroll
                for (int j = 0; j < 4; ++j) { u32x4 o; o.x = pk2(v[8 * j] * sc, v[8 * j + 1] * sc); o.y = pk2(v[8 * j + 2] * sc, v[8 * j + 3] * sc); o.z = pk2(v[8 * j + 4] * sc, v[8 * j + 5] * sc); o.w = pk2(v[8 * j + 6] * sc, v[8 * j + 7] * sc);
                    *((u32x4*)p + j) = o; }
            }
            if (tid < 384) {
                const int tok = tid / 6, vv = tid - tok * 6; const bool isq = vv < 4;
                bf16_t* p = proj + (size_t)(r0 + tok) * INW + (isq ? PC_Q + 64 * vv : PC_K + 64 * (vv - 4));
                const float* gain = (isq ? P.q_norm : P.k_norm) + (size_t)l * 64;
                float v[64]; float s2 = 0.f;
#pragma unroll
                for (int j = 0; j < 8; ++j) { const u32x4 w = *((const u32x4*)p + j);
                    v[8 * j + 0] = bflo(w.x); v[8 * j + 1] = bfhi(w.x); v[8 * j + 2] = bflo(w.y); v[8 * j + 3] = bfhi(w.y);
                    v[8 * j + 4] = bflo(w.z); v[8 * j + 5] = bfhi(w.z); v[8 * j + 6] = bflo(w.w); v[8 * j + 7] = bfhi(w.w); }
#pragma unroll
                for (int j = 0; j < 64; ++j) s2 += v[j] * v[j];
                const float rstd = 1.0f / sqrtf(s2 * (1.0f / 64.0f) + RMS_EPS);
#pragma unroll
                for (int j = 0; j < 64; ++j) v[j] = v[j] * rstd * gain[j];
                if (!is_ctx) { const int tl = t0 - CTX + tok; rope_half<16>(v, tl >> 6); rope_half<16>(v + 32, tl & 63); }
                const float sc = isq ? 0.125f * LOG2E : 1.0f;
#pragma unroll
                for (int j = 0; j < 8; ++j) { u32x4 o; o.x = pk2(v[8 * j] * sc, v[8 * j + 1] * sc); o.y = pk2(v[8 * j + 2] * sc, v[8 * j + 3] * sc); o.z = pk2(v[8 * j + 4] * sc, v[8 * j + 5] * sc); o.w = pk2(v[8 * j + 6] * sc, v[8 * j + 7] * sc);
                    *((u32x4*)p + j) = o; }
            }
#pragma unroll 1
            for (int rep = 0; rep < 6; ++rep) {
                const int id = tid + 512 * rep, cc = id % 384, ch = id / 384;
                const int col = (cc < 256) ? PA_V + cc : PC_V + (cc - 256);
                const bf16_t* p = proj + (size_t)(r0 + 8 * ch) * INW + col;
                unsigned e[8];
#pragma unroll
                for (int j = 0; j < 8; ++j) e[j] = p[(size_t)j * INW];
                u32x4 o; o.x = e[0] | (e[1] << 16); o.y = e[2] | (e[3] << 16); o.z = e[4] | (e[5] << 16); o.w = e[6] | (e[7] << 16);
                bf16_t* dst = (cc < 256) ? (bf16_t*)(P.ws + WS_VTA) + ((size_t)b * 256 + cc) * TT : (bf16_t*)(P.ws + WS_VTC) + ((size_t)b * 128 + (cc - 256)) * TT;
                *(u32x4*)(dst + t0 + 8 * ch) = o;
            }
        } else {
            float* U = (float*)lds;
            float* U2 = U + 64 * 256;
#pragma unroll
            for (int rep = 0; rep < 4; ++rep) {
                const int id = tid + 512 * rep, tok = id >> 5, ch = id & 31;
                const u32x4 w = *(const u32x4*)(proj + (size_t)(r0 + tok) * INW + PD_U + 8 * ch);
                f32x4 a0 = (f32x4){bflo(w.x), bfhi(w.x), bflo(w.y), bfhi(w.y)}, a1 = (f32x4){bflo(w.z), bfhi(w.z), bflo(w.w), bfhi(w.w)};
                float* d = U + tok * 256 + 8 * ch;
                if (!is_ctx) {
                    const int tg = t0 - CTX + tok, mt = (tg == 0) ? SEQ / 2 : SEQ - tg;
                    const u32x4 m = *(const u32x4*)(proj + ((size_t)b * TT + CTX + mt) * INW + PD_U + 8 * ch);
                    const f32x4 m0 = (f32x4){bflo(m.x), bfhi(m.x), bflo(m.y), bfhi(m.y)}, m1 = (f32x4){bflo(m.z), bfhi(m.z), bflo(m.w), bfhi(m.w)};
                    float* d2 = U2 + tok * 256 + 8 * ch;
                    if (tg == 0) { *(f32x4*)d2 = m0; *(f32x4*)(d2 + 4) = m1; }
                    else { *(f32x4*)d2 = a0 - m0; *(f32x4*)(d2 + 4) = a1 - m1; a0 = a0 + m0; a1 = a1 + m1; }
                }
                *(f32x4*)d = a0; *(f32x4*)(d + 4) = a1;
            }
            __syncthreads();
            const int n0 = (tid & 63) * 4, t8 = (tid >> 6) * 8, cp0 = n0 & 63, g = n0 >> 6;
            const bool sp0 = (!is_ctx) && (t0 == CTX) && (t8 == 0);
            float aC[4][8], aS[4][8];
#pragma unroll
            for (int q = 0; q < 4; ++q)
#pragma unroll
                for (int t = 0; t < 8; ++t) { aC[q][t] = 0.f; aS[q][t] = 0.f; }
            const float* ub = U + t8 * 256 + g * 64;
            const float* ub2 = is_ctx ? ub : ub + 64 * 256;
#pragma unroll 2
            for (int c = 0; c < 64; ++c) {
                float cv[4], sv[4];
#pragma unroll
                for (int q = 0; q < 4; ++q) { const float rev = (float)((c * (cp0 + q)) & 63) * (1.0f / 64.0f); cv[q] = __builtin_amdgcn_cosf(rev) * 0.125f; sv[q] = __builtin_amdgcn_sinf(rev) * 0.125f; }
#pragma unroll
                for (int t = 0; t < 8; ++t) { const float u = ub[t * 256 + c], u2 = ub2[t * 256 + c];
#pragma unroll
                    for (int q = 0; q < 4; ++q) { aC[q][t] += u * cv[q]; aS[q][t] += u2 * ((t == 0 && sp0) ? cv[q] : sv[q]); } }
            }
#pragma unroll
            for (int q = 0; q < 4; ++q) {
                const int n = n0 + q;
                bf16_t* dC; bf16_t* dS;
                if (is_ctx) { bf16_t* z = (bf16_t*)(P.ws + WS_ZCT) + ((size_t)b * 256 + n) * 512 + t0 + t8; dC = z; dS = z + 256; }
                else { bf16_t* z = (bf16_t*)(P.ws + WS_ZT) + ((size_t)b * 256 + n) * 2048 + (t0 - CTX) + t8; dC = z; dS = z + 1024; }
                u32x4 o; o.x = pk2(aC[q][0], aC[q][1]); o.y = pk2(aC[q][2], aC[q][3]); o.z = pk2(aC[q][4], aC[q][5]); o.w = pk2(aC[q][6], aC[q][7]);
                *(u32x4*)dC = o;
                u32x4 s4; s4.x = pk2(aS[q][0], aS[q][1]); s4.y = pk2(aS[q][2], aS[q][3]); s4.z = pk2(aS[q][4], aS[q][5]); s4.w = pk2(aS[q][6], aS[q][7]);
                *(u32x4*)dS = s4;
            }
            __syncthreads();
        }
    }
}

constexpr int AKT = 128;
constexpr int AK_PITCH = 144, AV_PITCH = 2 * AKT + 8  , AK_BYTES = AKT * AK_PITCH  , AV_BYTES = 64 * AV_PITCH  , A_BUF = AK_BYTES + AV_BYTES  ;
constexpr int A_NBUF = 3, A_XOFF = 0;
static_assert(A_NBUF * A_BUF <= LDS_RING && 4 * 32 * 64 * 4 <= A_BUF, "attention LDS");
__device__ __forceinline__ float max3f(float a, float b, float c) { return __builtin_fmaxf(__builtin_fmaxf(a, b), c); }
template <int DK> __device__ __forceinline__ void attn_qk(f32x16 (&p)[2], const LAS unsigned char* kb, const bf16x8 (&qf)[DK / 16]) {
#pragma unroll
    for (int j = 0; j < 2; ++j)
#pragma unroll
        for (int r = 0; r < 16; ++r) p[j][r] = 0.f;
#pragma unroll
    for (int i = 0; i < DK / 16; ++i)
#pragma unroll
        for (int j = 0; j < 2; ++j) {
            const bf16x8 kf = *(const LAS bf16x8*)(kb + j * 32 * AK_PITCH + i * 32);
            p[j] = __builtin_amdgcn_mfma_f32_32x32x16_bf16(kf, qf[i], p[j], 0, 0, 0);
        }
}
__device__ __forceinline__ void attn_softmax_pv(f32x16 (&p)[2], const LAS unsigned char* vb, float& m, float& lsum, f32x16& o0, f32x16& o1, int lane) {
    float ma = max3f(p[0][0], p[1][0], p[0][1]), mb = max3f(p[1][1], p[0][2], p[1][2]);
#pragma unroll
    for (int r = 3; r < 15; r += 2) { ma = max3f(ma, p[0][r], p[1][r]); mb = max3f(mb, p[0][r + 1], p[1][r + 1]); }
    ma = max3f(ma, p[0][15], p[1][15]);
    float mx = fmaxf(ma, mb);
    mx = fmaxf(mx, shx(mx, 32, lane));
    const float mn = fmaxf(m, mx);
    if (__builtin_amdgcn_ballot_w64(mn > m) != 0) {
        const float alpha = fast_exp2(m - mn); lsum *= alpha;
#pragma unroll
        for (int r = 0; r < 16; ++r) { o0[r] *= alpha; o1[r] *= alpha; }
        m = mn;
    }
    const f32x2_t m2 = {m, m};
    f32x2_t ls2 = {0.f, 0.f};
#pragma unroll
    for (int j = 0; j < 2; ++j)
#pragma unroll
        for (int r = 0; r < 16; r += 2) {
            f32x2_t d = (f32x2_t){p[j][r], p[j][r + 1]} - m2;
            d.x = fast_exp2(d.x); d.y = fast_exp2(d.y);
            ls2 += d; p[j][r] = d.x; p[j][r + 1] = d.y;
        }
    lsum += ls2.x + ls2.y;
#pragma unroll
    for (int ks = 0; ks < 4; ++ks) {
        const f32x16& pp = p[ks >> 1]; const int o8 = 8 * (ks & 1);
        u32x4 w; w.x = pk2(pp[o8], pp[o8 + 1]); w.y = pk2(pp[o8 + 2], pp[o8 + 3]); w.z = pk2(pp[o8 + 4], pp[o8 + 5]); w.w = pk2(pp[o8 + 6], pp[o8 + 7]);
        const bf16x8 pf = __builtin_bit_cast(bf16x8, w);
        const u32x2 a0 = *(const LAS u32x2*)(vb + ks * 32), a1 = *(const LAS u32x2*)(vb + ks * 32 + 16);
        const u32x2 c0 = *(const LAS u32x2*)(vb + 32 * AV_PITCH + ks * 32), c1 = *(const LAS u32x2*)(vb + 32 * AV_PITCH + ks * 32 + 16);
        const bf16x8 v0 = __builtin_bit_cast(bf16x8, ((u32x4){a0.x, a0.y, a1.x, a1.y})), v1 = __builtin_bit_cast(bf16x8, ((u32x4){c0.x, c0.y, c1.x, c1.y}));
        o0 = __builtin_amdgcn_mfma_f32_32x32x16_bf16(v0, pf, o0, 0, 0, 0);
        o1 = __builtin_amdgcn_mfma_f32_32x32x16_bf16(v1, pf, o1, 0, 0, 0);
    }
}
template <int DK, bool IS_A>
__device__ __forceinline__ void attn_unit(const Params& P, int l, LAS unsigned char* lds, int b, int grp, int qtok0, int nkeys) {
    const int tid = opaque_tid(), lane = tid & 63, wave = tid >> 6, s = wave >> 2, wq = wave & 3, r32 = lane & 31, hi = lane >> 5;
    const bf16_t* proj = (const bf16_t*)(P.ws + WS_PROJ);
    bf16_t* mix = (bf16_t*)(P.ws + WS_H);
    const int qcol = IS_A ? PA_Q + grp * 64 + s * 32 : PC_Q + (2 * grp + s) * 64;
    const int kcol = IS_A ? PA_K + grp * 64 : PC_K + grp * 64;
    const int koff = IS_A ? s * 32 : 0;
    const bf16_t* VT = IS_A ? (const bf16_t*)(P.ws + WS_VTA) + ((size_t)(b * 4 + grp) * 64) * TT : (const bf16_t*)(P.ws + WS_VTC) + ((size_t)(b * 2 + grp) * 64) * TT;
    const size_t qrow = (size_t)b * TT + qtok0 + wq * 64 + r32;
    bf16x8 qa[DK / 16], qb[DK / 16];
#pragma unroll
    for (int i = 0; i < DK / 16; ++i) { qa[i] = *(const bf16x8*)(proj + qrow * INW + qcol + i * 16 + hi * 8); qb[i] = *(const bf16x8*)(proj + (qrow + 32) * INW + qcol + i * 16 + hi * 8); }
    const int lrow = tid >> 3, lch = tid & 7;
    const bf16_t* ksrc = proj + ((size_t)b * TT + lrow) * INW + kcol + lch * 8;
    const bf16_t* vsrc = VT + (size_t)lrow * TT + lch * 8;
    const int NT = nkeys / AKT;
    u32x4 kreg0, kreg1, vreg0, vreg1;
#define AT_LOAD(t_) do { const bf16_t* kn = ksrc + (size_t)(t_) * AKT * INW; const bf16_t* vn = vsrc + (t_) * AKT; \
        kreg0 = *(const u32x4*)kn; kreg1 = *(const u32x4*)(kn + (size_t)64 * INW); vreg0 = *(const u32x4*)vn; vreg1 = *(const u32x4*)(vn + 64); } while (0)
#define AT_STORE(nb) do { LAS unsigned char* kd_ = lds + (nb) * A_BUF + lrow * AK_PITCH + lch * 16; LAS unsigned char* vd_ = lds + (nb) * A_BUF + AK_BYTES + lrow * AV_PITCH + lch * 16; \
        *(LAS u32x4*)kd_ = kreg0; *(LAS u32x4*)(kd_ + 64 * AK_PITCH) = kreg1; \
        *(LAS u32x2*)vd_ = (u32x2){vreg0.x, vreg0.y}; *(LAS u32x2*)(vd_ + 8) = (u32x2){vreg0.z, vreg0.w}; \
        *(LAS u32x2*)(vd_ + 128) = (u32x2){vreg1.x, vreg1.y}; *(LAS u32x2*)(vd_ + 136) = (u32x2){vreg1.z, vreg1.w}; } while (0)
    const int kfo = r32 * AK_PITCH + (koff + 8 * hi) * 2, vfo = AK_BYTES + r32 * AV_PITCH + 8 * hi;
    AT_LOAD(0); AT_STORE(0);
    __syncthreads();
    float ma = -1e30f, mb = -1e30f, la = 0.f, lb_ = 0.f;
    f32x16 oa0, oa1, ob0, ob1;
#pragma unroll
    for (int r = 0; r < 16; ++r) { oa0[r] = 0.f; oa1[r] = 0.f; ob0[r] = 0.f; ob1[r] = 0.f; }
    for (int t = 0; t < NT; ++t) {
        const int buf = t & 1;
        if (t + 1 < NT) AT_LOAD(t + 1);
#pragma unroll
        for (int h = 0; h < 2; ++h) {
            const LAS unsigned char* kb = lds + buf * A_BUF + kfo + h * 64 * AK_PITCH;
            const LAS unsigned char* vb = lds + buf * A_BUF + vfo + h * 128;
            f32x16 pa[2], pb[2];
#pragma unroll
            for (int jj = 0; jj < 2; ++jj)
#pragma unroll
                for (int r = 0; r < 16; ++r) { pa[jj][r] = 0.f; pb[jj][r] = 0.f; }
            __builtin_amdgcn_s_setprio(1);
#pragma unroll
            for (int i = 0; i < DK / 16; ++i)
#pragma unroll
                for (int jj = 0; jj < 2; ++jj) {
                    const bf16x8 kf = *(const LAS bf16x8*)(kb + jj * 32 * AK_PITCH + i * 32);
                    pa[jj] = __builtin_amdgcn_mfma_f32_32x32x16_bf16(kf, qa[i], pa[jj], 0, 0, 0);
                    pb[jj] = __builtin_amdgcn_mfma_f32_32x32x16_bf16(kf, qb[i], pb[jj], 0, 0, 0);
                }
            __builtin_amdgcn_s_setprio(0);
#define AT_SOFTMAX(PP, M, L, O0, O1) do { \
                float x0 = max3f(PP[0][0], PP[1][0], PP[0][1]), x1 = max3f(PP[1][1], PP[0][2], PP[1][2]); \
                _Pragma("unroll") for (int r = 3; r < 15; r += 2) { x0 = max3f(x0, PP[0][r], PP[1][r]); x1 = max3f(x1, PP[0][r + 1], PP[1][r + 1]); } \
                x0 = max3f(x0, PP[0][15], PP[1][15]); \
                float mx = fmaxf(x0, x1); mx = fmaxf(mx, shx(mx, 32, lane)); \
                const float mn = fmaxf(M, mx); \
                if (__builtin_amdgcn_ballot_w64(mn > M) != 0) { const float alpha = fast_exp2(M - mn); L *= alpha; \
                    _Pragma("unroll") for (int r = 0; r < 16; ++r) { O0[r] *= alpha; O1[r] *= alpha; } M = mn; } \
                float ls = 0.f; \
                _Pragma("unroll") for (int jj = 0; jj < 2; ++jj) _Pragma("unroll") for (int r = 0; r < 16; ++r) { PP[jj][r] = fast_exp2(PP[jj][r] - M); ls += PP[jj][r]; } \
                L += ls; } while (0)
            AT_SOFTMAX(pa, ma, la, oa0, oa1);
            AT_SOFTMAX(pb, mb, lb_, ob0, ob1);
#undef AT_SOFTMAX
#pragma unroll
            for (int ks = 0; ks < 4; ++ks) {
                const int o8 = 8 * (ks & 1);
                u32x4 w; const f32x16& xa = pa[ks >> 1]; const f32x16& xb = pb[ks >> 1];
                w.x = pk2(xa[o8], xa[o8 + 1]); w.y = pk2(xa[o8 + 2], xa[o8 + 3]); w.z = pk2(xa[o8 + 4], xa[o8 + 5]); w.w = pk2(xa[o8 + 6], xa[o8 + 7]);
                const bf16x8 pfa = __builtin_bit_cast(bf16x8, w);
                w.x = pk2(xb[o8], xb[o8 + 1]); w.y = pk2(xb[o8 + 2], xb[o8 + 3]); w.z = pk2(xb[o8 + 4], xb[o8 + 5]); w.w = pk2(xb[o8 + 6], xb[o8 + 7]);
                const bf16x8 pfb = __builtin_bit_cast(bf16x8, w);
                const u32x2 a0 = *(const LAS u32x2*)(vb + ks * 32), a1 = *(const LAS u32x2*)(vb + ks * 32 + 16);
                const u32x2 c0 = *(const LAS u32x2*)(vb + 32 * AV_PITCH + ks * 32), c1 = *(const LAS u32x2*)(vb + 32 * AV_PITCH + ks * 32 + 16);
                const bf16x8 v0 = __builtin_bit_cast(bf16x8, ((u32x4){a0.x, a0.y, a1.x, a1.y})), v1 = __builtin_bit_cast(bf16x8, ((u32x4){c0.x, c0.y, c1.x, c1.y}));
                oa0 = __builtin_amdgcn_mfma_f32_32x32x16_bf16(v0, pfa, oa0, 0, 0, 0);
                oa1 = __builtin_amdgcn_mfma_f32_32x32x16_bf16(v1, pfa, oa1, 0, 0, 0);
                ob0 = __builtin_amdgcn_mfma_f32_32x32x16_bf16(v0, pfb, ob0, 0, 0, 0);
                ob1 = __builtin_amdgcn_mfma_f32_32x32x16_bf16(v1, pfb, ob1, 0, 0, 0);
            }
        }
        if (t + 1 < NT) AT_STORE(buf ^ 1);
        __syncthreads();
    }
#undef AT_LOAD
#undef AT_STORE
    la += shx(la, 32, lane); lb_ += shx(lb_, 32, lane);
    { const float ia = 1.0f / la, ib = 1.0f / lb_;
#pragma unroll
      for (int r = 0; r < 16; ++r) { oa0[r] *= ia; oa1[r] *= ia; ob0[r] *= ib; ob1[r] *= ib; } }
#define AT_OUT(O0, O1, ROW, COL0, SCALE_G) do { bf16_t* orow = mix + (ROW) * DM + (COL0); \
        _Pragma("unroll") for (int db = 0; db < 2; ++db) _Pragma("unroll") for (int r4 = 0; r4 < 4; ++r4) { \
            const int d0 = 32 * db + 8 * r4 + 4 * hi; const f32x16& o = db ? O1 : O0; f32x4 g4 = (f32x4){1.f, 1.f, 1.f, 1.f}; \
            if (SCALE_G) g4 = *(const f32x4*)(gn + d0) * rs_; \
            u32x2 w; w.x = pk2(o[4 * r4] * g4.x, o[4 * r4 + 1] * g4.y); w.y = pk2(o[4 * r4 + 2] * g4.z, o[4 * r4 + 3] * g4.w); \
            *(u32x2*)(orow + d0) = w; } } while (0)
    if (IS_A) {
        LAS float* X = (LAS float*)lds;
        if (s == 1) {
#pragma unroll
            for (int r = 0; r < 16; ++r) { X[(wq * 64 + r) * 64 + lane] = oa0[r]; X[(wq * 64 + 16 + r) * 64 + lane] = oa1[r]; X[(wq * 64 + 32 + r) * 64 + lane] = ob0[r]; X[(wq * 64 + 48 + r) * 64 + lane] = ob1[r]; }
        }
        __syncthreads();
        if (s == 0) {
            const float lam = ((const float*)(P.ws + WS_CTL))[CW_LAM + l];
            const float oml_init = ((const float*)(P.ws + WS_CTL))[CW_LAM + 8 + l];
            const float* gn = P.diff_norm + (size_t)l * 64;
            float sa = 0.f, sb = 0.f;
#pragma unroll
            for (int r = 0; r < 16; ++r) {
                oa0[r] -= lam * X[(wq * 64 + r) * 64 + lane]; oa1[r] -= lam * X[(wq * 64 + 16 + r) * 64 + lane]; sa += oa0[r] * oa0[r] + oa1[r] * oa1[r];
                ob0[r] -= lam * X[(wq * 64 + 32 + r) * 64 + lane]; ob1[r] -= lam * X[(wq * 64 + 48 + r) * 64 + lane]; sb += ob0[r] * ob0[r] + ob1[r] * ob1[r]; }
            sa += shx(sa, 32, lane); sb += shx(sb, 32, lane);
            { const float rs_ = (1.0f / sqrtf(sa * (1.0f / 64.0f) + RMS_EPS)) * oml_init; AT_OUT(oa0, oa1, qrow, grp * 64, true); }
            { const float rs_ = (1.0f / sqrtf(sb * (1.0f / 64.0f) + RMS_EPS)) * oml_init; AT_OUT(ob0, ob1, qrow + 32, grp * 64, true); }
        }
        __syncthreads();
    } else {
        const float* gn = nullptr; const float rs_ = 1.f;
        AT_OUT(oa0, oa1, qrow, 512 + (2 * grp + s) * 64, false);
        AT_OUT(ob0, ob1, qrow + 32, 512 + (2 * grp + s) * 64, false);
    }
#undef AT_OUT
}

__device__ __forceinline__ void hgrn_unit(const Params& P, int l, LAS unsigned char* lds, int b, int h, int dir) {
    const int tid = opaque_tid(), lane = tid & 63, wave = tid >> 6;
    const bf16_t* proj = (const bf16_t*)(P.ws + WS_PROJ);
    float* odir = (float*)(P.ws + WS_ODIR) + (size_t)dir * ROWS * 256;
    constexpr int HC = 32, NCH = TT / HC;
    LAS float* Kk = (LAS float*)lds; LAS float* Q = Kk + HC * 64; LAS float* V = Q + HC * 64; LAS float* Pp = V + HC * 64;
    const int d0 = 4 * (tid & 15), sst = tid >> 4;
    const f32x4 lb4 = *(const f32x4*)((const float*)(P.ws + WS_CTL) + CW_LB + ((size_t)dir * DEPTH + l) * 256 + h * 64 + d0);
    const f32x4 oml = 1.0f - lb4;
    const int zc = (dir ? PB_FB : PB_FF) + h * 64 + d0, qc = PB_Q + h * 64 + d0, vc = PB_I + h * 64 + d0;
    u32x2 rq, rz, rv;
#define HG_CHUNK(ci) (dir ? (((ci) < 8) ? 7 - (ci) : 79 - (ci)) : (ci))
#define HG_TOK(ci) ((size_t)b * TT + HG_CHUNK(ci) * HC + (dir ? HC - 1 - sst : sst))
#define HG_LOAD(ci) do { const bf16_t* pr_ = proj + HG_TOK(ci) * INW; rq = *(const u32x2*)(pr_ + qc); rz = *(const u32x2*)(pr_ + zc); rv = *(const u32x2*)(pr_ + vc); } while (0)
    HG_LOAD(0);
    float S[8];
#pragma unroll
    for (int i = 0; i < 8; ++i) S[i] = 0.f;
    for (int ci = 0; ci < NCH; ++ci) {
        {
            f32x4 sg; sg.x = sigmoidf_(-bflo(rz.x)); sg.y = sigmoidf_(-bfhi(rz.x)); sg.z = sigmoidf_(-bflo(rz.y)); sg.w = sigmoidf_(-bfhi(rz.y));
            *(LAS f32x4*)(Kk + sst * 64 + d0) = oml * sg;
            *(LAS f32x4*)(Q + sst * 64 + d0) = (f32x4){bflo(rq.x), bfhi(rq.x), bflo(rq.y), bfhi(rq.y)};
            *(LAS f32x4*)(V + sst * 64 + d0) = (f32x4){bflo(rv.x), bfhi(rv.x), bflo(rv.y), bfhi(rv.y)};
        }
        __syncthreads();
        if (ci + 1 < NCH) HG_LOAD(ci + 1);
        const LAS float* kp = Kk + 8 * wave; const LAS float* qp = Q + 8 * wave; const LAS float* vp = V + lane; LAS float* pp = Pp + wave * (HC * 64) + lane;
        f32x4 ka = *(const LAS f32x4*)kp, kb = *(const LAS f32x4*)(kp + 4), qa = *(const LAS f32x4*)qp, qb = *(const LAS f32x4*)(qp + 4);
        float v = vp[0];
#pragma unroll 4
        for (int st = 0; st < HC; ++st) {
            const int sn = (st + 1) & (HC - 1);
            const f32x4 nka = *(const LAS f32x4*)(kp + sn * 64), nkb = *(const LAS f32x4*)(kp + sn * 64 + 4), nqa = *(const LAS f32x4*)(qp + sn * 64), nqb = *(const LAS f32x4*)(qp + sn * 64 + 4);
            const float nv = vp[sn * 64];
            S[0] += ka.x * (v - S[0]); S[1] += ka.y * (v - S[1]); S[2] += ka.z * (v - S[2]); S[3] += ka.w * (v - S[3]);
            S[4] += kb.x * (v - S[4]); S[5] += kb.y * (v - S[5]); S[6] += kb.z * (v - S[6]); S[7] += kb.w * (v - S[7]);
            pp[st * 64] = ((S[0] * qa.x + S[1] * qa.y) + (S[2] * qa.z + S[3] * qa.w)) + ((S[4] * qb.x + S[5] * qb.y) + (S[6] * qb.z + S[7] * qb.w));
            ka = nka; kb = nkb; qa = nqa; qb = nqb; v = nv;
        }
        __syncthreads();
        {
            f32x4 o = *(const LAS f32x4*)(Pp + sst * 64 + d0);
#pragma unroll
            for (int w = 1; w < 8; ++w) o = o + *(const LAS f32x4*)(Pp + w * (HC * 64) + sst * 64 + d0);
            *(f32x4*)(odir + HG_TOK(ci) * 256 + h * 64 + d0) = o;
        }
    }
    __syncthreads();
#undef HG_CHUNK
#undef HG_TOK
#undef HG_LOAD
}

constexpr int HM_QP = 144, HM_QT = 0, HM_KT = 2304, HM_KD = 4608, HM_VT = 6656, HM_EB = 8704, HM_WAVE = 8960;
__device__ __forceinline__ void hm_stage(LAS unsigned char* wl, const unsigned (&rq)[16], const unsigned (&rz)[16], const unsigned (&rv)[16], float oml, int lane) {
    float kt[16]; float run = 1.0f;
    unsigned vpk[8];
#pragma unroll
    for (int i = 0; i < 16; ++i) {
        const float z = bf2f(rz[i]), q = bf2f(rq[i]);
        const float sg = __builtin_amdgcn_rcpf(1.0f + fast_exp2(z * LOG2E));
        const float k = oml * sg;
        run = fmaxf(run * (1.0f - k), 8.673617379884035e-19f);
        const float ieb = __builtin_amdgcn_rcpf(run);
        kt[i] = k * ieb;
        *(LAS unsigned short*)(wl + HM_QT + i * HM_QP + lane * 2) = (unsigned short)pk2(q * run, 0.f);
        *(LAS unsigned short*)(wl + HM_KT + i * HM_QP + lane * 2) = (unsigned short)pk2(kt[i], 0.f);
        if (i & 1) vpk[i >> 1] = rv[i - 1] | (rv[i] << 16);
    }
    const float eB = run;
    *(LAS float*)(wl + HM_EB + lane * 4) = eB;
    u32x4 w0, w1;
    w0.x = pk2(kt[0] * eB, kt[1] * eB); w0.y = pk2(kt[2] * eB, kt[3] * eB); w0.z = pk2(kt[4] * eB, kt[5] * eB); w0.w = pk2(kt[6] * eB, kt[7] * eB);
    w1.x = pk2(kt[8] * eB, kt[9] * eB); w1.y = pk2(kt[10] * eB, kt[11] * eB); w1.z = pk2(kt[12] * eB, kt[13] * eB); w1.w = pk2(kt[14] * eB, kt[15] * eB);
    *(LAS u32x4*)(wl + HM_KD + lane * 32) = w0; *(LAS u32x4*)(wl + HM_KD + lane * 32 + 16) = w1;
    *(LAS u32x4*)(wl + HM_VT + lane * 32) = (u32x4){vpk[0], vpk[1], vpk[2], vpk[3]}; *(LAS u32x4*)(wl + HM_VT + lane * 32 + 16) = (u32x4){vpk[4], vpk[5], vpk[6], vpk[7]};
}
__device__ __forceinline__ void hm_mfma(const LAS unsigned char* wl, f32x4 (&S)[4][4], f32x4 (&o)[4], int c16, int g) {
    const bf16x8 zero8 = {0, 0, 0, 0, 0, 0, 0, 0};
    f32x4 sc = (f32x4){0.f, 0.f, 0.f, 0.f};
#pragma unroll
    for (int kk = 0; kk < 2; ++kk) {
        const bf16x8 a = *(const LAS bf16x8*)(wl + HM_KT + c16 * HM_QP + (32 * kk + 8 * g) * 2);
        const bf16x8 bq = *(const LAS bf16x8*)(wl + HM_QT + c16 * HM_QP + (32 * kk + 8 * g) * 2);
        sc = __builtin_amdgcn_mfma_f32_16x16x32_bf16(a, bq, sc, 0, 0, 0);
    }
#pragma unroll
    for (int r = 0; r < 4; ++r) if (4 * g + r > c16) sc[r] = 0.f;
    bf16x8 pb; { u32x4 w; w.x = pk2(sc[0], sc[1]); w.y = pk2(sc[2], sc[3]); w.z = 0u; w.w = 0u; pb = __builtin_bit_cast(bf16x8, w); }
    bf16x8 qb[2];
#pragma unroll
    for (int kk = 0; kk < 2; ++kk) {
        const u32x2 lo = *(const LAS u32x2*)(wl + HM_QT + c16 * HM_QP + (32 * kk + 4 * g) * 2), hi2 = *(const LAS u32x2*)(wl + HM_QT + c16 * HM_QP + (32 * kk + 16 + 4 * g) * 2);
        qb[kk] = __builtin_bit_cast(bf16x8, ((u32x4){lo.x, lo.y, hi2.x, hi2.y}));
    }
#pragma unroll
    for (int eb = 0; eb < 4; ++eb) {
        const u32x2 va = *(const LAS u32x2*)(wl + HM_VT + (16 * eb + c16) * 32 + 8 * g);
        const bf16x8 a = __builtin_bit_cast(bf16x8, ((u32x4){va.x, va.y, 0u, 0u}));
        f32x4 acc = __builtin_amdgcn_mfma_f32_16x16x32_bf16(a, pb, (f32x4){0.f, 0.f, 0.f, 0.f}, 0, 0, 0);
#pragma unroll
        for (int kk = 0; kk < 2; ++kk) {
            const f32x4 s0 = S[2 * kk][eb], s1 = S[2 * kk + 1][eb];
            u32x4 w; w.x = pk2(s0[0], s0[1]); w.y = pk2(s0[2], s0[3]); w.z = pk2(s1[0], s1[1]); w.w = pk2(s1[2], s1[3]);
            acc = __builtin_amdgcn_mfma_f32_16x16x32_bf16(__builtin_bit_cast(bf16x8, w), qb[kk], acc, 0, 0, 0);
        }
        o[eb] = acc;
    }
    bf16x8 af[4], bf[4]; f32x4 e4[4];
#pragma unroll
    for (int x = 0; x < 4; ++x) {
        af[x] = (g < 2) ? *(const LAS bf16x8*)(wl + HM_KD + (16 * x + c16) * 32 + 16 * g) : zero8;
        bf[x] = (g < 2) ? *(const LAS bf16x8*)(wl + HM_VT + (16 * x + c16) * 32 + 16 * g) : zero8;
        e4[x] = *(const LAS f32x4*)(wl + HM_EB + (16 * x + 4 * g) * 4);
    }
#pragma unroll
    for (int mb = 0; mb < 4; ++mb)
#pragma unroll
        for (int nb = 0; nb < 4; ++nb) S[mb][nb] = __builtin_amdgcn_mfma_f32_16x16x32_bf16(af[mb], bf[nb], S[mb][nb] * e4[mb], 0, 0, 0);
}
__device__ __forceinline__ void hgrn_mfma_unit(const Params& P, int l, LAS unsigned char* lds, int b, int half) {
    const int tid = opaque_tid(), lane = tid & 63, wave = tid >> 6, c16 = lane & 15, g = lane >> 4;
    if (wave < 4) {
        const int idx = 4 * half + wave, h = idx >> 1, dir = idx & 1;
        const bf16_t* proj = (const bf16_t*)(P.ws + WS_PROJ);
        float* odir = (float*)(P.ws + WS_ODIR) + (size_t)dir * ROWS * 256;
        LAS unsigned char* wl = lds + wave * HM_WAVE;
        const float lb = ((const float*)(P.ws + WS_CTL))[CW_LB + ((size_t)dir * DEPTH + l) * 256 + h * 64 + lane];
        const float oml = 1.0f - lb;
        const int qc = PB_Q + h * 64 + lane, zc = (dir ? PB_FB : PB_FF) + h * 64 + lane, vc = PB_I + h * 64 + lane;
        const size_t tb = (size_t)b * TT;
#define HM_TOK(p_) (tb + (dir ? (((p_) < CTX) ? (CTX - 1 - (p_)) : (TT + CTX - 1 - (p_))) : (p_)))
#define HM_LOAD(RQ, RZ, RV, j_) do { _Pragma("unroll") for (int i = 0; i < 16; ++i) { const bf16_t* pr_ = proj + HM_TOK((j_) * 16 + i) * INW; RQ[i] = pr_[qc]; RZ[i] = pr_[zc]; RV[i] = pr_[vc]; } } while (0)
#define HM_STORE_O(j_) do { float* op = odir + HM_TOK((j_) * 16 + c16) * 256 + h * 64 + 4 * g; _Pragma("unroll") for (int eb = 0; eb < 4; ++eb) *(f32x4*)(op + 16 * eb) = o[eb]; } while (0)
        unsigned aq[16], az[16], av[16], bq[16], bz[16], bv[16];
        HM_LOAD(aq, az, av, 0); HM_LOAD(bq, bz, bv, 1);
        f32x4 S[4][4];
#pragma unroll
        for (int mb = 0; mb < 4; ++mb)
#pragma unroll
            for (int nb = 0; nb < 4; ++nb) S[mb][nb] = (f32x4){0.f, 0.f, 0.f, 0.f};
        f32x4 o[4];
        constexpr int NSC = TT / 16;
        for (int j = 0; j < NSC; j += 2) {
            hm_stage(wl, aq, az, av, oml, lane);
            if (j + 2 < NSC) HM_LOAD(aq, az, av, j + 2);
            hm_mfma(wl, S, o, c16, g);
            HM_STORE_O(j);
            hm_stage(wl, bq, bz, bv, oml, lane);
            if (j + 3 < NSC) HM_LOAD(bq, bz, bv, j + 3);
            hm_mfma(wl, S, o, c16, g);
            HM_STORE_O(j + 1);
        }
#undef HM_TOK
#undef HM_LOAD
#undef HM_STORE_O
    }
    __syncthreads();
}

__device__ __forceinline__ void phase_mix(const Params& P, int l, unsigned char* lds_g, int rep = 0) {
    LAS unsigned char* lds = (LAS unsigned char*)lds_g;
    unsigned* ctr = (unsigned*)(P.ws + WS_CTL) + CW_QUEUE + 64 * (l + DEPTH * rep);
    volatile LAS int* slot = (volatile LAS int*)(lds + LDS_MISC);
    const bool need_ctx = l < DEPTH - 1;
    constexpr int N_H = 32, N_F = 128, N_A = 512, N_C = 256, N_FC = 16, N_AC = 64, N_CC = 32;
    const int total = N_H + N_F + N_A + N_C + (need_ctx ? N_FC + N_AC + N_CC : 0);
    for (;;) {
        if (opaque_tid() == 0) *slot = (int)atomicAdd(ctr, 1u);
        __syncthreads();
        int it = *slot;
        __syncthreads();
        if (it >= total) break;
        if (it < N_F) {
            pg8::Gemm g{(const pg8::bf16_t*)(P.ws + WS_FMAT), (const pg8::bf16_t*)(P.ws + WS_ZT), SEQ, NBATCH * 256, 2048}; OneUnit S{it & 7, it >> 3};
            pg8::EpiBf16<0> E{(pg8::bf16_t*)(P.ws + WS_H) + (size_t)CTX * DM + 768, DM, nullptr, 256, (size_t)TT * DM, 1.0f};
            pg8::gemm_phase<pg8::EpiBf16<0>, OneUnit, false, true>(lds, g, S, E); __syncthreads(); continue; } it -= N_F;
        if (it < N_H) { hgrn_mfma_unit(P, l, lds, it >> 1, it & 1); continue; } it -= N_H;
        if (it < N_C) { attn_unit<64, false>(P, l, lds, it >> 4, (it >> 3) & 1, CTX + (it & 7) * 256, TT); continue; } it -= N_C;
        if (it < N_A) { attn_unit<32, true>(P, l, lds, it >> 5, (it >> 3) & 3, CTX + (it & 7) * 256, TT); continue; } it -= N_A;
        if (it < N_FC) {
            pg8::Gemm g{(const pg8::bf16_t*)(P.ws + WS_FC), (const pg8::bf16_t*)(P.ws + WS_ZCT), CTX, NBATCH * 256, 512}; OneUnit S{0, it};
            pg8::EpiBf16<0> E{(pg8::bf16_t*)(P.ws + WS_H) + 768, DM, nullptr, 256, (size_t)TT * DM, 1.0f};
            pg8::gemm_phase<pg8::EpiBf16<0>, OneUnit, false, true>(lds, g, S, E); __syncthreads(); continue; } it -= N_FC;
        if (it < N_AC) { attn_unit<32, true>(P, l, lds, it >> 2, it & 3, 0, CTX); continue; } it -= N_AC;
        attn_unit<64, false>(P, l, lds, it >> 1, it & 1, 0, CTX);
    }
}

__device__ __forceinline__ void phase_hfin(const Params& P, int l) {
    const float* od0 = (const float*)(P.ws + WS_ODIR); const float* od1 = od0 + (size_t)ROWS * 256;
    const bf16_t* proj = (const bf16_t*)(P.ws + WS_PROJ); bf16_t* mix = (bf16_t*)(P.ws + WS_H);
    const float* gn = P.hgrn_norm + (size_t)l * 64;
    const long total = (long)ROWS * 4 * 16;
    const int tid = opaque_tid(), lane = tid & 63;
    for (long i = (long)blockIdx.x * 512 + tid; i < total; i += (long)gridDim.x * 512) {
        const int sub = (int)(i & 15); const long rh = i >> 4; const int h = (int)(rh & 3); const long r = rh >> 2;
        const size_t off = (size_t)r * 256 + h * 64 + sub * 4;
        const f32x4 a = *(const f32x4*)(od0 + off), b2 = *(const f32x4*)(od1 + off);
        const f32x4 o = a + b2;
        float ss = (o.x * o.x + o.y * o.y) + (o.z * o.z + o.w * o.w);
        ss += shx(ss, 1, lane); ss += shx(ss, 2, lane); ss += shx(ss, 4, lane); ss += shx(ss, 8, lane);
        const float rs = 1.0f / sqrtf(ss * (1.0f / 64.0f) + RMS_EPS);
        const u32x2 gw = *(const u32x2*)(proj + (size_t)r * INW + PB_G + h * 64 + sub * 4);
        const float g0 = bflo(gw.x), g1 = bfhi(gw.x), g2 = bflo(gw.y), g3 = bfhi(gw.y);
        const f32x4 gg = *(const f32x4*)(gn + sub * 4);
        u32x2 w; w.x = pk2(o.x * rs * gg.x * (g0 * sigmoidf_(g0)), o.y * rs * gg.y * (g1 * sigmoidf_(g1))); w.y = pk2(o.z * rs * gg.z * (g2 * sigmoidf_(g2)), o.w * rs * gg.w * (g3 * sigmoidf_(g3)));
        *(u32x2*)(mix + (size_t)r * DM + 256 + h * 64 + sub * 4) = w;
    }
}

#define XB_TMO      128
#define XB_XCNT(j)  (256  + 64 * (j))
#define XB_XSUB(j)  (1280 + 64 * (j))
#define XB_XGEN(j)  (2304 + 64 * (j))
#define XB_TOP      3328
#define XB_TOPGEN   3392
#define XCD_BAR_WORDS 3456
#define XB_SPIN_CAP (1u << 18)

__device__ __forceinline__ unsigned xb_ld(unsigned* p)              { return __hip_atomic_load(p, __ATOMIC_RELAXED, __HIP_MEMORY_SCOPE_AGENT); }
__device__ __forceinline__ unsigned xb_add(unsigned* p, unsigned v) { return __hip_atomic_fetch_add(p, v, __ATOMIC_RELAXED, __HIP_MEMORY_SCOPE_AGENT); }
__device__ __forceinline__ unsigned xb_xcc_id() { return (unsigned)__builtin_amdgcn_s_getreg((3 << 11) | 20) & 0xFu; }
#define XB_SPIN(cond, bar) do { unsigned _sp = 0; while (cond) { __builtin_amdgcn_s_sleep(1); \
    if ((++_sp & 255u) == 0u) { if (xb_ld(&(bar)[XB_TMO])) break; if (_sp > XB_SPIN_CAP) { atomicAdd(&(bar)[XB_TMO], 1u); break; } } } } while (0)

struct XcdBarrier {
    unsigned* bar; unsigned x;
    volatile LAS unsigned* st;
};

__device__ __forceinline__ XcdBarrier xcd_barrier_post(unsigned* bar, volatile LAS unsigned* st) {
    XcdBarrier b; b.bar = bar; b.x = xb_xcc_id(); b.st = st;
    if (threadIdx.x == 0) (void)xb_add(&bar[XB_XCNT(b.x)], 1u);
    return b;
}
__device__ __forceinline__ void xcd_barrier_complete(unsigned* bar, unsigned x, unsigned& nloc, unsigned& nx) {
    const unsigned G = gridDim.x * gridDim.y * gridDim.z;
    unsigned sum, cnt, mine, sp = 0u;
    for (;;) {
        sum = 0u; cnt = 0u; mine = 0u;
#pragma unroll
        for (unsigned j = 0; j < 16; ++j) { const unsigned c = xb_ld(&bar[XB_XCNT(j)]); sum += c; cnt += (c > 0u) ? 1u : 0u; mine = (j == x) ? c : mine; }
        if (sum == G) break;
        __builtin_amdgcn_s_sleep(1);
        if ((++sp & 255u) == 0u) { if (xb_ld(&bar[XB_TMO])) break; if (sp > XB_SPIN_CAP) { atomicAdd(&bar[XB_TMO], 1u); break; } }
    }
    nloc = mine > 0u ? mine : 1u; nx = cnt > 0u ? cnt : 1u;
}

__device__ __forceinline__ void xcd_barrier(const XcdBarrier& b) {
    asm volatile("s_waitcnt vmcnt(0)" ::: "memory");
    __syncthreads();
    if (threadIdx.x == 0) {
        unsigned* bar = b.bar;
        __builtin_amdgcn_s_waitcnt(0);
        unsigned nloc = b.st[0], nx = b.st[1];
        if (nloc == 0u) { xcd_barrier_complete(bar, b.x, nloc, nx); b.st[0] = nloc; b.st[1] = nx; }
        const unsigned old = xb_add(&bar[XB_XSUB(b.x)], 1u);
        const unsigned gen = old / nloc;
        if (old + 1u == (gen + 1u) * nloc) {
            __builtin_amdgcn_fence(__ATOMIC_RELEASE, "agent");
            asm volatile("s_waitcnt vmcnt(0)" ::: "memory");
            const unsigned og = xb_add(&bar[XB_TOP], 1u);
            const unsigned tg = og / nx;
            if (og + 1u == (tg + 1u) * nx) xb_add(&bar[XB_TOPGEN], 1u);
            else XB_SPIN(xb_ld(&bar[XB_TOPGEN]) == tg, bar);
            __builtin_amdgcn_fence(__ATOMIC_ACQUIRE, "agent");
            xb_add(&bar[XB_XGEN(b.x)], 1u);
            asm volatile("s_waitcnt vmcnt(0)" ::: "memory");
        } else {
            XB_SPIN(xb_ld(&bar[XB_XGEN(b.x)]) == gen, bar);
            __builtin_amdgcn_fence(__ATOMIC_ACQUIRE, "agent");
            asm volatile("s_waitcnt vmcnt(0)" ::: "memory");
        }
    }
    __syncthreads();
}

static_assert(XCD_BAR_WORDS_C == XCD_BAR_WORDS, "barrier words");
#ifndef RES_ALIGN
#define RES_ALIGN true
#endif
#ifndef REP_MIX
#define REP_MIX 1
#endif
#ifndef REP_G1
#define REP_G1 1
#endif
#ifndef REP_G3
#define REP_G3 1
#endif
#ifndef REP_PREPD
#define REP_PREPD 1
#endif
typedef const __attribute__((address_space(4))) Params* KParams;
__device__ __forceinline__ Params fresh_params() {
#if defined(__HIP_DEVICE_COMPILE__)
    KParams q = (KParams)__builtin_amdgcn_kernarg_segment_ptr(); asm volatile("" : "+s"(q)); return *q;
#else
    return Params{};
#endif
}
__global__ void __launch_bounds__(512, 2) hybrid_fwd(Params Parg) {
    extern __shared__ __attribute__((aligned(16))) unsigned char lds[];
    cg::grid_group grid = cg::this_grid();
    LAS unsigned char* ldsl = (LAS unsigned char*)lds;
    volatile LAS unsigned* bst = (volatile LAS unsigned*)(ldsl + LDS_MISC + 64);
    if (threadIdx.x == 0) { bst[0] = 0u; bst[1] = 0u; }
    { const Params P = fresh_params(); phase_init(P, lds); }
    grid.sync();
    XcdBarrier bar;
    { const Params P = fresh_params(); bar = xcd_barrier_post((unsigned*)(P.ws + WS_CTL) + CW_BAR, bst); }
#pragma unroll 1
    for (int l = 0; l < DEPTH; ++l) {
        const bool lat_only = (l == DEPTH - 1);
        { const Params P = fresh_params(); phase_norm(P, l, 0, l == 0); if (l == 0) convert_weights(P, 0, lds, 0); }
        xcd_barrier(bar);
        for (int rep = 0; rep < REP_G1; ++rep) {
        { const Params P = fresh_params(); const int G = gridDim.x, blk = blockIdx.x;
          pg8::Gemm g{(const pg8::bf16_t*)(P.ws + WS_H), (const pg8::bf16_t*)(P.ws + (size_t)(l & 1) * WS_WBUF + WS_W), ROWS, INW, DM}; pg8::StaticOrder S; S.init(ROWS, INW, G, blk);
          pg8::EpiBf16<0> E{(pg8::bf16_t*)(P.ws + WS_PROJ), INW, nullptr, 0, 0, 1.0f};
          pg8::gemm_phase<pg8::EpiBf16<0>, pg8::StaticOrder, true, true>(ldsl, g, S, E); }
        xcd_barrier(bar);
        }
        { const Params P = fresh_params(); phase_prep(P, l, lds); }
        xcd_barrier(bar);
#ifdef PROBE_HG
        { const Params P = fresh_params(); if (blockIdx.x < 128) hgrn_unit(P, l, ldsl, blockIdx.x >> 3, (blockIdx.x >> 1) & 3, blockIdx.x & 1); }
        xcd_barrier(bar);
#endif
        for (int rep = 0; rep < REP_MIX; ++rep) { { const Params P = fresh_params(); phase_mix(P, l, lds, rep); }
        xcd_barrier(bar); }
        { const Params P = fresh_params(); phase_hfin(P, l); }
        xcd_barrier(bar);
#ifdef PROBE_HF
        { const Params P = fresh_params(); phase_hfin(P, l); }
        xcd_barrier(bar);
#endif
#ifdef PROBE_SYNC
        for (int i = 0; i < 10; ++i) xcd_barrier(bar);
#endif
        { const Params P = fresh_params(); const int G = gridDim.x, blk = blockIdx.x;
          const float* modl = (const float*)(P.ws + WS_MOD) + (size_t)l * 17 * MODW;
          pg8::Gemm g{(const pg8::bf16_t*)(P.ws + WS_H), (const pg8::bf16_t*)(P.ws + (size_t)(l & 1) * WS_WBUF + WS_W_OUT), ROWS, DM, DM};
          EpiResid E{P.out, (float*)(P.ws + WS_XC), modl + 2 * DM};
          if (lat_only) { LatOrder S; S.init(DM, G, blk); pg8::gemm_phase<EpiResid, LatOrder, RES_ALIGN, true>(ldsl, g, S, E); }
          else { pg8::StaticOrder S; S.init(ROWS, DM, G, blk); pg8::gemm_phase<EpiResid, pg8::StaticOrder, RES_ALIGN, true>(ldsl, g, S, E); } }
        xcd_barrier(bar);
        { const Params P = fresh_params(); phase_norm(P, l, 1, false); }
        xcd_barrier(bar);
#ifdef PROBE_N2
        { const Params P = fresh_params(); phase_norm(P, l, 1, false); }
        xcd_barrier(bar);
#endif
        for (int rep = 0; rep < REP_G3; ++rep) {
        { const Params P = fresh_params(); const int G = gridDim.x, blk = blockIdx.x;
          pg8::Gemm g{(const pg8::bf16_t*)(P.ws + WS_H), (const pg8::bf16_t*)(P.ws + (size_t)(l & 1) * WS_WBUF + WS_W_FI), ROWS, 2 * FFH, DM};
          EpiSwiGLU E{(bf16_t*)(P.ws + WS_PROJ)};
          if (lat_only) { LatOrder S; S.init(2 * FFH, G, blk); pg8::gemm_phase<EpiSwiGLU, LatOrder, true, true>(ldsl, g, S, E); }
          else { pg8::StaticOrder S; S.init(ROWS, 2 * FFH, G, blk); pg8::gemm_phase<EpiSwiGLU, pg8::StaticOrder, true, true>(ldsl, g, S, E); } }
        xcd_barrier(bar);
        }
        { const Params P = fresh_params(); const int G = gridDim.x, blk = blockIdx.x;
          const float* modl = (const float*)(P.ws + WS_MOD) + (size_t)l * 17 * MODW;
          pg8::Gemm g{(const pg8::bf16_t*)(P.ws + WS_PROJ), (const pg8::bf16_t*)(P.ws + (size_t)(l & 1) * WS_WBUF + WS_W_FO), ROWS, DM, FFH};
          EpiResid E{P.out, (float*)(P.ws + WS_XC), modl + 5 * DM};
          if (lat_only) { LatOrder S; S.init(DM, G, blk); pg8::gemm_phase<EpiResid, LatOrder, RES_ALIGN, true>(ldsl, g, S, E); }
          else { pg8::StaticOrder S; S.init(ROWS, DM, G, blk); pg8::gemm_phase<EpiResid, pg8::StaticOrder, RES_ALIGN, true>(ldsl, g, S, E); }
          if (l + 1 < DEPTH) { __syncthreads(); convert_weights(P, l + 1, lds, lat_only ? 0 : 64); } }
        xcd_barrier(bar);
    }
    { const Params P = fresh_params(); phase_final(P); }
}

extern "C" void kernel_launch(void* const* d_in, const int* in_sizes, int n_in, void* d_out, int out_size, void* d_ws, size_t ws_size, hipStream_t stream) {
    static int grid = 0;
    if (grid == 0) {
        if (n_in != 19 || ws_size < WS_END) { fprintf(stderr, "kernel_launch: unexpected n_in %d / ws_size %zu\n", n_in, ws_size); grid = -1; return; }
        int dev = 0, cus = 0, per_cu = 0;
        (void)hipGetDevice(&dev);
        (void)hipDeviceGetAttribute(&cus, hipDeviceAttributeMultiprocessorCount, dev);
        (void)hipFuncSetAttribute((const void*)hybrid_fwd, hipFuncAttributeMaxDynamicSharedMemorySize, LDS_BYTES);
        (void)hipOccupancyMaxActiveBlocksPerMultiprocessor(&per_cu, (const void*)hybrid_fwd, 512, LDS_BYTES);
        if (per_cu < 1) { fprintf(stderr, "kernel_launch: occupancy query says %d blocks per CU\n", per_cu); per_cu = 1; }
        grid = cus * 1;
        (void)hipGetLastError();
    }
    if (grid < 0) return;
    Params p{};
    const float** pp = (const float**)&p;
    for (int i = 0; i < 19; ++i) pp[i] = (const float*)d_in[i];
    p.out = (float*)d_out; p.ws = (unsigned char*)d_ws;
    void* args[] = {&p};
    hipError_t e = hipLaunchCooperativeKernel((const void*)hybrid_fwd, dim3(grid), dim3(512), args, LDS_BYTES, stream);
    if (e != hipSuccess) fprintf(stderr, "cooperative launch failed: %s (grid %d)\n", hipGetErrorString(e), grid);
}
```
